# Optimizing an MI355X kernel written in HIP

```python
import jax, jax.numpy as jnp
from jax import lax
import numpy as np

D_MODEL = 4096
BATCH = 8
SEQ = 2048
DEPTH = 2

HEAD_DIM = 128
N_HEADS_TOTAL = D_MODEL // HEAD_DIM
NSA_HEADS = N_HEADS_TOTAL // 2
NSA_KV_HEADS = NSA_HEADS // 4
NSA_GROUP = NSA_HEADS // NSA_KV_HEADS
SB_HEADS = N_HEADS_TOTAL - NSA_HEADS
CMP_BLOCK = 32
CMP_STRIDE = 16
SEL_BLOCK = 64
SEL_TOP_N = 16
WINDOW = 512
Q_BLOCK = 128
SEL_Q_BLOCK = 32
ROPE_THETA = 10000.0
POOL_GROUPS = 4
POOL_WINDOWS = (2, 4, 8, 16)
POOL_GROUP_DIM = D_MODEL // POOL_GROUPS
D_FF = 11008
CONV_WIDTH = 3
LN_EPS = 1e-5
NEG_INF = -1e30
FORCE_SCORE = 1e9
DEEPNORM_ALPHA = (2 * DEPTH) ** 0.25
DEEPNORM_BETA = (8 * DEPTH) ** -0.25
N_ATTN_LAYERS = (DEPTH + 1) // 2
N_POOL_LAYERS = DEPTH // 2

Q_NSA_DIM = NSA_HEADS * HEAD_DIM
KV_NSA_DIM = NSA_KV_HEADS * HEAD_DIM
GATE_DIM = 3 * NSA_HEADS
SB_DIM = SB_HEADS * HEAD_DIM
IN_SEGMENTS = (Q_NSA_DIM, KV_NSA_DIM, KV_NSA_DIM, KV_NSA_DIM, KV_NSA_DIM, KV_NSA_DIM, KV_NSA_DIM,
               GATE_DIM, SB_DIM, SB_DIM, SB_DIM)
IN_VALUE_SEGMENT = (False, False, True, False, True, False, True, False, False, False, True)
IN_DIM = sum(IN_SEGMENTS)

kernel_name = "nsa_stickbreak_pool_convffn_deepnorm"


def layer_norm(x, g, b):
    xf = x.astype(jnp.float32)
    mu = xf.mean(-1, keepdims=True)
    var = jnp.square(xf - mu).mean(-1, keepdims=True)
    return ((xf - mu) * lax.rsqrt(var + LN_EPS) * g + b).astype(x.dtype)


def rope_cos_sin(pos):
    inv_freq = 1.0 / (ROPE_THETA ** (jnp.arange(0, HEAD_DIM, 2, dtype=jnp.float32) / HEAD_DIM))
    ang = pos.astype(jnp.float32)[:, None] * inv_freq[None, :]
    return jnp.cos(ang), jnp.sin(ang)


def apply_rope(x, cos, sin):
    xf = x.astype(jnp.float32)
    x1, x2 = xf[..., :HEAD_DIM // 2], xf[..., HEAD_DIM // 2:]
    c, s = cos[None, :, None, :], sin[None, :, None, :]
    return jnp.concatenate([x1 * c - x2 * s, x1 * s + x2 * c], axis=-1).astype(x.dtype)


def nsa_attention(q, k_cmp, v_cmp, k_slc, v_slc, k_win, v_win, gate_logits,
                  w_cmp_k, w_cmp_v, pe_cmp_k, pe_cmp_v):
    B, T = q.shape[:2]
    scale = HEAD_DIM ** -0.5
    qg = q.reshape(B, T, NSA_KV_HEADS, NSA_GROUP, HEAD_DIM)
    t_pos = jnp.arange(T)

    n_cmp = (T - CMP_BLOCK) // CMP_STRIDE + 1
    blk_idx = np.arange(n_cmp)[:, None] * CMP_STRIDE + np.arange(CMP_BLOCK)[None, :]
    kc_blocks = k_cmp[:, blk_idx] + pe_cmp_k[None, None, :, None, :]
    vc_blocks = v_cmp[:, blk_idx] + pe_cmp_v[None, None, :, None, :]
    kc = jnp.einsum('bnlhd,lde->bnhe', kc_blocks, w_cmp_k)
    vc = jnp.einsum('bnlhd,lde->bnhe', vc_blocks, w_cmp_v)
    cmp_end = np.arange(n_cmp) * CMP_STRIDE + CMP_BLOCK - 1
    c_cos, c_sin = rope_cos_sin(jnp.asarray(cmp_end))
    kc = apply_rope(kc, c_cos, c_sin)
    valid_cmp = jnp.asarray(cmp_end)[None, :] <= t_pos[:, None]
    s_cmp = jnp.einsum('btkgd,bnkd->bkgtn', qg, kc).astype(jnp.float32) * scale
    s_cmp = jnp.where(valid_cmp, s_cmp, NEG_INF)
    p_cmp = jax.nn.softmax(s_cmp, axis=-1) * valid_cmp.any(-1, keepdims=True)
    o_cmp = jnp.einsum('bkgtn,bnkd->btkgd', p_cmp.astype(vc.dtype), vc)

    n_blk = T // SEL_BLOCK
    c_start = np.arange(n_cmp)[:, None] * CMP_STRIDE
    b_start = np.arange(n_blk)[None, :] * SEL_BLOCK
    overlap = np.clip(np.minimum(c_start + CMP_BLOCK, b_start + SEL_BLOCK) - np.maximum(c_start, b_start), 0, None)
    overlap = jnp.asarray(overlap / CMP_BLOCK, jnp.float32)
    imp = jnp.einsum('bkgtn,nj->bktj', p_cmp, overlap)
    blk = jnp.arange(n_blk)[None, :]
    cur = (t_pos // SEL_BLOCK)[:, None]
    forced = (blk == 0) | (blk == cur) | (blk == cur - 1)
    valid_blk = blk * SEL_BLOCK <= t_pos[:, None]
    imp = jnp.where(forced, FORCE_SCORE, jnp.where(valid_blk, imp, NEG_INF))
    n_top = min(SEL_TOP_N, n_blk)
    _, sel_idx = lax.top_k(imp, n_top)

    ks_blocks = k_slc.reshape(B, n_blk, SEL_BLOCK, NSA_KV_HEADS, HEAD_DIM).transpose(0, 3, 1, 2, 4)
    vs_blocks = v_slc.reshape(B, n_blk, SEL_BLOCK, NSA_KV_HEADS, HEAD_DIM).transpose(0, 3, 1, 2, 4)
    n_sq = T // SEL_Q_BLOCK
    q_sel = qg.reshape(B, n_sq, SEL_Q_BLOCK, NSA_KV_HEADS, NSA_GROUP, HEAD_DIM).transpose(1, 0, 2, 3, 4, 5)
    idx_sel = sel_idx.reshape(B, NSA_KV_HEADS, n_sq, SEL_Q_BLOCK, n_top).transpose(2, 0, 1, 3, 4)
    gather = jax.vmap(jax.vmap(lambda blocks, ids: blocks[ids]))

    def sel_chunk(args):
        qc, ic, start = args
        kg = gather(ks_blocks, ic)
        vg = gather(vs_blocks, ic)
        s = jnp.einsum('bqkgd,bkqnld->bkgqnl', qc, kg).astype(jnp.float32) * scale
        kpos = ic[..., None] * SEL_BLOCK + jnp.arange(SEL_BLOCK)
        tq = start + jnp.arange(SEL_Q_BLOCK)
        mask = kpos <= tq[None, None, :, None, None]
        s = jnp.where(mask[:, :, None], s, NEG_INF)
        p = jax.nn.softmax(s.reshape(s.shape[:4] + (-1,)), axis=-1).reshape(s.shape)
        return jnp.einsum('bkgqnl,bkqnld->bqkgd', p.astype(vg.dtype), vg)

    o_slc = lax.map(sel_chunk, (q_sel, idx_sel, jnp.arange(n_sq) * SEL_Q_BLOCK))
    o_slc = o_slc.transpose(1, 0, 2, 3, 4, 5).reshape(B, T, NSA_KV_HEADS, NSA_GROUP, HEAD_DIM)

    kw_pad = jnp.pad(k_win, ((0, 0), (WINDOW, 0), (0, 0), (0, 0)))
    vw_pad = jnp.pad(v_win, ((0, 0), (WINDOW, 0), (0, 0), (0, 0)))
    n_qb = T // Q_BLOCK
    q_win = qg.reshape(B, n_qb, Q_BLOCK, NSA_KV_HEADS, NSA_GROUP, HEAD_DIM).transpose(1, 0, 2, 3, 4, 5)

    def win_chunk(args):
        qc, start = args
        kb = lax.dynamic_slice_in_dim(kw_pad, start, WINDOW + Q_BLOCK, axis=1)
        vb = lax.dynamic_slice_in_dim(vw_pad, start, WINDOW + Q_BLOCK, axis=1)
        s = jnp.einsum('bqkgd,bskd->bkgqs', qc, kb).astype(jnp.float32) * scale
        tq = start + jnp.arange(Q_BLOCK)
        kpos = start - WINDOW + jnp.arange(WINDOW + Q_BLOCK)
        diff = tq[:, None] - kpos[None, :]
        mask = (diff >= 0) & (diff < WINDOW) & (kpos >= 0)[None, :]
        p = jax.nn.softmax(jnp.where(mask, s, NEG_INF), axis=-1)
        return jnp.einsum('bkgqs,bskd->bqkgd', p.astype(vb.dtype), vb)

    o_win = lax.map(win_chunk, (q_win, jnp.arange(n_qb) * Q_BLOCK))
    o_win = o_win.transpose(1, 0, 2, 3, 4, 5).reshape(B, T, NSA_KV_HEADS, NSA_GROUP, HEAD_DIM)

    g = jax.nn.sigmoid(gate_logits.astype(jnp.float32)).astype(q.dtype)
    g = g.reshape(B, T, 3, NSA_KV_HEADS, NSA_GROUP, 1)
    o = g[:, :, 0] * o_cmp + g[:, :, 1] * o_slc + g[:, :, 2] * o_win
    return o.reshape(B, T, NSA_HEADS * HEAD_DIM)


def stick_breaking_attention(q, k, v):
    B, T, H, _ = q.shape
    scale = HEAD_DIM ** -0.5
    n_qb = T // Q_BLOCK
    q_blocks = q.reshape(B, n_qb, Q_BLOCK, H, HEAD_DIM).transpose(1, 0, 2, 3, 4)
    kpos = jnp.arange(T)

    def chunk(args):
        qc, start = args
        z = jnp.einsum('bqhd,bshd->bhqs', qc, k).astype(jnp.float32) * scale
        tq = start + jnp.arange(Q_BLOCK)
        mask = kpos[None, :] < tq[:, None]
        neg_log_1m_beta = jnp.where(mask, jax.nn.softplus(z), 0.0)
        later = lax.cumsum(neg_log_1m_beta, axis=3, reverse=True) - neg_log_1m_beta
        a = jnp.where(mask, jnp.exp(jax.nn.log_sigmoid(z) - later), 0.0)
        return jnp.einsum('bhqs,bshd->bqhd', a.astype(v.dtype), v)

    o = lax.map(chunk, (q_blocks, jnp.arange(n_qb) * Q_BLOCK))
    return o.transpose(1, 0, 2, 3, 4).reshape(B, T, H * HEAD_DIM)


def attention_mixer(x, w_in, w_out, w_cmp_k, w_cmp_v, pe_cmp_k, pe_cmp_v):
    B, T, _ = x.shape
    h = jnp.einsum('btd,de->bte', x, w_in)
    cuts = [int(c) for c in np.cumsum(IN_SEGMENTS)[:-1]]
    q_a, kc, vc, ks, vs, kw, vw, gates, q_b, k_b, v_b = jnp.split(h, cuts, axis=-1)
    heads = lambda t, n: t.reshape(B, T, n, HEAD_DIM)
    cos, sin = rope_cos_sin(jnp.arange(T))
    q_a = apply_rope(heads(q_a, NSA_HEADS), cos, sin)
    ks = apply_rope(heads(ks, NSA_KV_HEADS), cos, sin)
    kw = apply_rope(heads(kw, NSA_KV_HEADS), cos, sin)
    o_a = nsa_attention(q_a, heads(kc, NSA_KV_HEADS), heads(vc, NSA_KV_HEADS), ks, heads(vs, NSA_KV_HEADS),
                        kw, heads(vw, NSA_KV_HEADS), gates, w_cmp_k, w_cmp_v, pe_cmp_k, pe_cmp_v)
    o_b = stick_breaking_attention(heads(q_b, SB_HEADS), heads(k_b, SB_HEADS), heads(v_b, SB_HEADS))
    return jnp.einsum('bte,ed->btd', jnp.concatenate([o_a, o_b], axis=-1), w_out)


def pool_mixer(x, w_pool, pool_scale):
    B, T, D = x.shape
    cs = jnp.cumsum(x.astype(jnp.float32), axis=1)
    t = jnp.arange(T)
    diffs = []
    for gi, w in enumerate(POOL_WINDOWS):
        sl = slice(gi * POOL_GROUP_DIM, (gi + 1) * POOL_GROUP_DIM)
        csg = cs[..., sl]
        prev = jnp.pad(csg, ((0, 0), (w, 0), (0, 0)))[:, :T]
        count = jnp.minimum(t + 1, w).astype(jnp.float32)[None, :, None]
        diffs.append((csg - prev) / count - x[..., sl].astype(jnp.float32))
    d = jnp.stack(diffs, axis=2).astype(x.dtype)
    y = jnp.einsum('btgc,gce->btge', d, w_pool).reshape(B, T, D)
    return y * pool_scale


def conv_ffn(x, w_up, conv_w, conv_b, w_down):
    T = x.shape[1]
    h = jnp.einsum('btd,df->btf', x, w_up)
    hp = jnp.pad(h, ((0, 0), (CONV_WIDTH - 1, 0), (0, 0)))
    hc = conv_b
    for k in range(CONV_WIDTH):
        hc = hc + hp[:, k:k + T] * conv_w[k]
    gate, val = jnp.split(hc, 2, axis=-1)
    return jnp.einsum('btf,fd->btd', jax.nn.silu(gate) * val, w_down)


def setup_inputs(seed: int = 0) -> dict:
    key = jax.random.key(seed)
    ks = jax.random.split(key, 18)
    nrm = lambda k, shape, s: jax.random.normal(k, shape, jnp.float32) * s
    col_scale = np.concatenate([np.full(n, DEEPNORM_BETA if v else 1.0, np.float32)
                                for n, v in zip(IN_SEGMENTS, IN_VALUE_SEGMENT)])
    return {
        "x": nrm(ks[0], (BATCH, SEQ, D_MODEL), 1.0),
        "attn_w_in": nrm(ks[1], (N_ATTN_LAYERS, D_MODEL, IN_DIM), D_MODEL ** -0.5) * jnp.asarray(col_scale),
        "attn_w_out": nrm(ks[2], (N_ATTN_LAYERS, D_MODEL, D_MODEL), D_MODEL ** -0.5 * DEEPNORM_BETA),
        "cmp_w_k": nrm(ks[3], (N_ATTN_LAYERS, CMP_BLOCK, HEAD_DIM, HEAD_DIM), (CMP_BLOCK * HEAD_DIM) ** -0.5),
        "cmp_w_v": nrm(ks[4], (N_ATTN_LAYERS, CMP_BLOCK, HEAD_DIM, HEAD_DIM), (CMP_BLOCK * HEAD_DIM) ** -0.5),
        "cmp_pe_k": nrm(ks[5], (N_ATTN_LAYERS, CMP_BLOCK, HEAD_DIM), 0.1),
        "cmp_pe_v": nrm(ks[6], (N_ATTN_LAYERS, CMP_BLOCK, HEAD_DIM), 0.1),
        "pool_w": nrm(ks[7], (N_POOL_LAYERS, POOL_GROUPS, POOL_GROUP_DIM, POOL_GROUP_DIM),
                       POOL_GROUP_DIM ** -0.5 * DEEPNORM_BETA),
        "pool_scale": 1.0 + nrm(ks[8], (N_POOL_LAYERS, D_MODEL), 0.1),
        "ffn_w_up": nrm(ks[9], (DEPTH, D_MODEL, 2 * D_FF), D_MODEL ** -0.5),
        "ffn_conv_w": nrm(ks[10], (DEPTH, CONV_WIDTH, 2 * D_FF), CONV_WIDTH ** -0.5),
        "ffn_conv_b": nrm(ks[11], (DEPTH, 2 * D_FF), 0.02),
        "ffn_w_down": nrm(ks[12], (DEPTH, D_FF, D_MODEL), D_FF ** -0.5 * DEEPNORM_BETA),
        "ln_mix_g": 1.0 + nrm(ks[13], (DEPTH, D_MODEL), 0.05),
        "ln_mix_b": nrm(ks[14], (DEPTH, D_MODEL), 0.02),
        "ln_ffn_g": 1.0 + nrm(ks[15], (DEPTH, D_MODEL), 0.05),
        "ln_ffn_b": nrm(ks[16], (DEPTH, D_MODEL), 0.02),
    }


def reference(x, attn_w_in, attn_w_out, cmp_w_k, cmp_w_v, cmp_pe_k, cmp_pe_v, pool_w, pool_scale,
              ffn_w_up, ffn_conv_w, ffn_conv_b, ffn_w_down, ln_mix_g, ln_mix_b, ln_ffn_g, ln_ffn_b):
    for layer in range(DEPTH):
        i = layer // 2
        if layer % 2 == 0:
            m = attention_mixer(x, attn_w_in[i], attn_w_out[i], cmp_w_k[i], cmp_w_v[i], cmp_pe_k[i], cmp_pe_v[i])
        else:
            m = pool_mixer(x, pool_w[i], pool_scale[i])
        x = layer_norm(DEEPNORM_ALPHA * x + m, ln_mix_g[layer], ln_mix_b[layer])
        f = conv_ffn(x, ffn_w_up[layer], ffn_conv_w[layer], ffn_conv_b[layer], ffn_w_down[layer])
        x = layer_norm(DEEPNORM_ALPHA * x + f, ln_ffn_g[layer], ln_ffn_b[layer])
    return x
```

```cpp
#include <hip/hip_runtime.h>
#include <cstdio>
#include <cstdint>
namespace pg8 {
#define PG8_LAS __attribute__((address_space(3)))
typedef unsigned short bf16_t;
typedef short bf16x8 __attribute__((ext_vector_type(8)));
typedef float f32x4 __attribute__((ext_vector_type(4)));
typedef unsigned u32x4 __attribute__((ext_vector_type(4)));
typedef _Float16 h8 __attribute__((ext_vector_type(8)));
typedef _Float16 h4 __attribute__((ext_vector_type(4)));
constexpr int BM = 256, BK = 64, HALF = 128, HTB = HALF * BK * 2  , STAGE_BYTES = 8 * HTB, NXCD = 8, WGM = 8;

__host__ __device__ __forceinline__ int lds_byte(int r, int c) { const int st = (r >> 4) * 2 + (c >> 5), rr = r & 15, cc = c & 31, ob = rr * 64 + cc * 2; return st * 1024 + (ob ^ (((ob >> 9) & 1) << 5)); }
__host__ __device__ __forceinline__ void stage_rc(int b, int& R, int& C) { const int st = b / 1024, sb = b % 1024, swz = sb ^ (((sb >> 9) & 1) << 5); R = (st >> 1) * 16 + swz / 64; C = (st & 1) * 32 + (swz % 64) / 2; }
__host__ __device__ __forceinline__ int perm32(int rho) { const int n = rho >> 4, i = rho & 15; return 8 * (i >> 2) + 4 * n + (i & 3); }

struct Unit { int pm, pn; };
struct Gemm { const bf16_t* A; const bf16_t* Bt; int M, N, K, lda, ldb, agrp; };

struct StaticOrder {
    int nM, nN, nwg, G, c, wgm, pair;
    __host__ __device__ void init(int M, int N, int G_, int c_) { nM = M / BM; nN = N / BM; nwg = nM * nN; G = G_; c = c_; wgm = WGM; pair = 0; }
    __host__ __device__ bool next(int i, Unit& u) const {
        const long L = (long)i * G + c; if (L >= nwg) return false;
        if (pair && nN == 16 && (nM & 15) == 0 && nwg == 128 * NXCD) {
            const int xcd = (int)(L % NXCD), off = (int)(L / NXCD), j = xcd >> 1, half = xcd & 1, r = off >> 5, idx = off & 31;
            u.pm = 16 * j + 4 * r + (idx & 3); u.pn = 8 * half + (idx >> 2); return true; }
        int wgid = (int)L; { const int q = nwg / NXCD, r = nwg % NXCD, xcd = wgid % NXCD, off = wgid / NXCD; wgid = (xcd < r ? xcd * (q + 1) : r * (q + 1) + (xcd - r) * q) + off; }
        const int nig = wgm * nN, gid = wgid / nig, fm = gid * wgm, gsz = (nM - fm) < wgm ? (nM - fm) : wgm;
        u.pm = fm + ((wgid % nig) % gsz); u.pn = (wgid % nig) / gsz; return true;
    }
    __device__ __forceinline__ void a_ready(const Unit&) const {}
    __device__ __forceinline__ void done(const Unit&) const {}
};

__device__ __forceinline__ unsigned cvt_pk_bf16(float lo, float hi) { unsigned r; asm volatile("v_cvt_pk_bf16_f32 %0, %1, %2" : "=v"(r) : "v"(lo), "v"(hi)); return r; }
typedef float f32x2 __attribute__((ext_vector_type(2)));
__device__ __forceinline__ f32x2 gelu_pk(f32x2 v) {
    const f32x2 av = __builtin_elementwise_abs(v), d = av * 0.2316418882f + 1.0f;
    f32x2 t; t.x = __builtin_amdgcn_rcpf(d.x); t.y = __builtin_amdgcn_rcpf(d.y);
    f32x2 q = t * 0.5307027145f + (-0.7265760135f); q = q * t + 0.7107068705f; q = q * t + (-0.142248368f); q = q * t + 0.127414796f; q = q * t;
    const f32x2 s = (v * v) * (-0.72134752044f);
    f32x2 e; e.x = __builtin_amdgcn_exp2f(s.x); e.y = __builtin_amdgcn_exp2f(s.y);
    const f32x2 m = v * (q * e), r = v - m;
    f32x2 o; o.x = v.x < 0.f ? m.x : r.x; o.y = v.y < 0.f ? m.y : r.y; return o;
}

template <int ACT  > struct EpiBf16 {
    struct Pre {}; __device__ __forceinline__ void preload(const Unit&, Pre&, int, int) const {}
    static constexpr bool PERM = true, AFTER_DRAIN = false, APERM = false; static_assert(ACT == 0 || ACT == 1, "EpiBf16: ACT is 0 (none) or 1 (gelu_pk)");
    bf16_t* O; int ldc; const float* bias; int split_cols; size_t split_stride; float scale0;
    __device__ __forceinline__ void operator()(const f32x4 (&acc)[2][2][4][2], const Unit& u, int wr, int wc, int fr, int fq, const Pre&) const {
        const int row0 = u.pm * BM + wr * 64 + fr; int colt = u.pn * BM; bf16_t* base = O;
        float sc = 1.f; if (split_cols) { const int t = colt / split_cols; base += (size_t)t * split_stride; colt -= t * split_cols; if (t == 0) sc = scale0; }
        const int col0 = colt + wc * 32 + 8 * fq, bcol0 = u.pn * BM + wc * 32 + 8 * fq;
        f32x4 bv[2][2];
#pragma unroll
        for (int bj = 0; bj < 2; ++bj)
#pragma unroll
            for (int n = 0; n < 2; ++n) bv[bj][n] = bias ? *(const f32x4*)(bias + bcol0 + bj * HALF + 4 * n) : (f32x4){0.f, 0.f, 0.f, 0.f};
#pragma unroll
        for (int ai = 0; ai < 2; ++ai)
#pragma unroll
            for (int m = 0; m < 4; ++m) { bf16_t* rowp = base + (size_t)(row0 + ai * HALF + m * 16) * ldc + col0;
#pragma unroll
                for (int bj = 0; bj < 2; ++bj) { f32x4 v0 = acc[ai][bj][m][0] + bv[bj][0], v1 = acc[ai][bj][m][1] + bv[bj][1];
                    if (ACT == 1) { f32x2 a = gelu_pk((f32x2){v0[0], v0[1]}), b = gelu_pk((f32x2){v0[2], v0[3]}), c = gelu_pk((f32x2){v1[0], v1[1]}), d = gelu_pk((f32x2){v1[2], v1[3]});
                        v0 = (f32x4){a.x, a.y, b.x, b.y}; v1 = (f32x4){c.x, c.y, d.x, d.y}; }
                    v0 = v0 * sc; v1 = v1 * sc; u32x4 w; w.x = cvt_pk_bf16(v0[0], v0[1]); w.y = cvt_pk_bf16(v0[2], v0[3]); w.z = cvt_pk_bf16(v1[0], v1[1]); w.w = cvt_pk_bf16(v1[2], v1[3]);
                    *(u32x4*)(rowp + bj * HALF) = w; } }
    }
};

struct EpiInProj {
    struct Pre {}; __device__ __forceinline__ void preload(const Unit&, Pre&, int, int) const {}
    static constexpr bool PERM = true, AFTER_DRAIN = false, APERM = false;
    bf16_t* O; int mrows; const float* cs; const float* sn;
    static __device__ __forceinline__ bool is_rope(int hb) { return (hb < 16) || (hb >= 24 && hb < 28) || (hb >= 32 && hb < 36); }
    __device__ __forceinline__ void operator()(const f32x4 (&acc)[2][2][4][2], const Unit& u, int wr, int wc, int fr, int fq, const Pre&) const {
        const int row0 = u.pm * BM + wr * 64 + fr, pcol = wc * 32 + 8 * fq, i0 = 4 * (4 * wc + fq);
        const bool rp0 = is_rope(2 * u.pn), rp1 = is_rope(2 * u.pn + 1);
        f32x4 cc[2][4], ss[2][4];
#pragma unroll
        for (int ai = 0; ai < 2; ++ai)
#pragma unroll
            for (int m = 0; m < 4; ++m) { cc[ai][m] = (f32x4){1.f, 1.f, 1.f, 1.f}; ss[ai][m] = (f32x4){0.f, 0.f, 0.f, 0.f}; }
        if (rp0 || rp1) {
#pragma unroll
            for (int ai = 0; ai < 2; ++ai)
#pragma unroll
                for (int m = 0; m < 4; ++m) { const int t = (row0 + ai * HALF + m * 16) & 2047; cc[ai][m] = *(const f32x4*)(cs + t * 64 + i0); ss[ai][m] = *(const f32x4*)(sn + t * 64 + i0); }
            asm volatile("" :: "v"(cc[0][0]), "v"(cc[0][1]), "v"(cc[0][2]), "v"(cc[0][3]), "v"(cc[1][0]), "v"(cc[1][1]), "v"(cc[1][2]), "v"(cc[1][3]),
                               "v"(ss[0][0]), "v"(ss[0][1]), "v"(ss[0][2]), "v"(ss[0][3]), "v"(ss[1][0]), "v"(ss[1][1]), "v"(ss[1][2]), "v"(ss[1][3]) : "memory"); }
#pragma unroll
        for (int ai = 0; ai < 2; ++ai)
#pragma unroll
            for (int m = 0; m < 4; ++m) { const int row = row0 + ai * HALF + m * 16;
#pragma unroll
                for (int bj = 0; bj < 2; ++bj) { const int hb = 2 * u.pn + bj; const bool rope = bj ? rp1 : rp0;
                    f32x4 v0 = acc[ai][bj][m][0], v1 = acc[ai][bj][m][1];
                    if (rope) { const f32x4 c = cc[ai][m], s = ss[ai][m]; const f32x4 r0 = v0 * c - v1 * s, r1 = v0 * s + v1 * c; v0 = r0; v1 = r1; }
                    u32x4 w; w.x = cvt_pk_bf16(v0[0], v0[1]); w.y = cvt_pk_bf16(v0[2], v0[3]); w.z = cvt_pk_bf16(v1[0], v1[1]); w.w = cvt_pk_bf16(v1[2], v1[3]);
                    *(u32x4*)(O + ((size_t)hb * mrows + row) * HALF + pcol) = w; } }
    }
};
struct EpiResStats {
    struct Pre {}; __device__ __forceinline__ void preload(const Unit&, Pre&, int, int) const {}
    static constexpr bool PERM = true, AFTER_DRAIN = false, APERM = false;
    _Float16* Y; const float* res; const float* stats; const float* lg; const float* lb; const float* cscale; int ldc; float alpha;
    __device__ __forceinline__ void operator()(const f32x4 (&acc)[2][2][4][2], const Unit& u, int wr, int wc, int fr, int fq, const Pre&) const {
        const int row0 = u.pm * BM + wr * 64 + fr, col0 = u.pn * BM + wc * 32 + 8 * fq;
        f32x4 sv[2][2], gv[2][2], bv[2][2];
#pragma unroll
        for (int bj = 0; bj < 2; ++bj)
#pragma unroll
            for (int n = 0; n < 2; ++n) { const int c = col0 + bj * HALF + 4 * n; sv[bj][n] = cscale ? *(const f32x4*)(cscale + c) : (f32x4){1.f, 1.f, 1.f, 1.f};
                gv[bj][n] = stats ? *(const f32x4*)(lg + c) : (f32x4){1.f, 1.f, 1.f, 1.f}; bv[bj][n] = stats ? *(const f32x4*)(lb + c) : (f32x4){0.f, 0.f, 0.f, 0.f}; }
        const unsigned e0 = (unsigned)(row0 * ldc + col0), estep = (unsigned)(16 * ldc);
#pragma unroll
        for (int ai = 0; ai < 2; ++ai) {
            if (stats) {
#pragma unroll
              for (int mb = 0; mb < 4; mb += 2) { h8 yv[2][2]; float mu[2], rs[2];
#pragma unroll
                for (int m = 0; m < 2; ++m) { const unsigned row = (unsigned)(row0 + ai * HALF + (mb + m) * 16), off = e0 + (unsigned)(ai * 8 + mb + m) * estep;
                    yv[m][0] = *(const h8*)(Y + off); yv[m][1] = *(const h8*)(Y + (off + HALF)); mu[m] = stats[2 * row]; rs[m] = stats[2 * row + 1]; }
                asm volatile("" :: "v"(yv[0][0]), "v"(yv[0][1]), "v"(yv[1][0]), "v"(yv[1][1]), "v"(mu[0]), "v"(mu[1]), "v"(rs[0]), "v"(rs[1]) : "memory");
#pragma unroll
                for (int m = 0; m < 2; ++m) { const unsigned off = e0 + (unsigned)(ai * 8 + mb + m) * estep;
#pragma unroll
                    for (int bj = 0; bj < 2; ++bj) { const h8 y = yv[m][bj];
                        f32x4 r0 = (f32x4){(float)y[0], (float)y[1], (float)y[2], (float)y[3]}, r1 = (f32x4){(float)y[4], (float)y[5], (float)y[6], (float)y[7]};
                        r0 = (r0 - mu[m]) * rs[m] * gv[bj][0] + bv[bj][0]; r1 = (r1 - mu[m]) * rs[m] * gv[bj][1] + bv[bj][1];
                        const f32x4 o0 = r0 * alpha + acc[ai][bj][mb + m][0] * sv[bj][0], o1 = r1 * alpha + acc[ai][bj][mb + m][1] * sv[bj][1];
                        h8 w; w[0] = (_Float16)o0[0]; w[1] = (_Float16)o0[1]; w[2] = (_Float16)o0[2]; w[3] = (_Float16)o0[3]; w[4] = (_Float16)o1[0]; w[5] = (_Float16)o1[1]; w[6] = (_Float16)o1[2]; w[7] = (_Float16)o1[3];
                        *(h8*)(Y + (off + bj * HALF)) = w; } }
                asm volatile("" ::: "memory"); } }
            else {
#pragma unroll
              for (int mb = 0; mb < 4; mb += 2) { f32x4 rv[2][2][2];
#pragma unroll
                for (int m = 0; m < 2; ++m) { const unsigned off = e0 + (unsigned)(ai * 8 + mb + m) * estep;
#pragma unroll
                    for (int bj = 0; bj < 2; ++bj) { rv[m][bj][0] = *(const f32x4*)(res + (off + bj * HALF)); rv[m][bj][1] = *(const f32x4*)(res + (off + bj * HALF + 4)); } }
                asm volatile("" :: "v"(rv[0][0][0]), "v"(rv[0][0][1]), "v"(rv[0][1][0]), "v"(rv[0][1][1]), "v"(rv[1][0][0]), "v"(rv[1][0][1]), "v"(rv[1][1][0]), "v"(rv[1][1][1]) : "memory");
#pragma unroll
                for (int m = 0; m < 2; ++m) { const unsigned off = e0 + (unsigned)(ai * 8 + mb + m) * estep;
#pragma unroll
                    for (int bj = 0; bj < 2; ++bj) {
                        const f32x4 o0 = rv[m][bj][0] * alpha + acc[ai][bj][mb + m][0] * sv[bj][0], o1 = rv[m][bj][1] * alpha + acc[ai][bj][mb + m][1] * sv[bj][1];
                        h8 w; w[0] = (_Float16)o0[0]; w[1] = (_Float16)o0[1]; w[2] = (_Float16)o0[2]; w[3] = (_Float16)o0[3]; w[4] = (_Float16)o1[0]; w[5] = (_Float16)o1[1]; w[6] = (_Float16)o1[2]; w[7] = (_Float16)o1[3];
                        *(h8*)(Y + (off + bj * HALF)) = w; } }
                asm volatile("" ::: "memory"); } } }
    }
};
struct EpiUpConv {
    static constexpr bool PERM = true, AFTER_DRAIN = false, APERM = true;
    bf16_t* A2; const float* pk; float* halo; PG8_LAS unsigned char* xch; int dff, nup;
    struct Pre { f32x4 v; };
    __device__ __forceinline__ void preload(const Unit& u, Pre& p, int wc, int lane) const { p.v = *(const f32x4*)(pk + ((size_t)(u.pn * 4 + wc) * 64 + lane) * 4); }
    static __device__ __forceinline__ float shr1(float cur, float first) { return __int_as_float(__builtin_amdgcn_update_dpp(__float_as_int(first), __float_as_int(cur), 0x111, 0xf, 0xf, false)); }
    __device__ __forceinline__ void operator()(const f32x4 (&acc_)[2][2][4][2], const Unit& u, int wr, int wc, int fr, int fq, const Pre& pre) const {
        typedef unsigned u32x2 __attribute__((ext_vector_type(2)));
        const f32x4 (&acc)[2][2][4][2] = acc_;
        const int cl = wc * 32 + 8 * fq, f0 = u.pn * 128 + cl;
        PG8_LAS unsigned char* pblk = xch + 6144 + (wr * 4 + wc) * 1024;
        *(PG8_LAS f32x4*)(pblk + (fr + 16 * fq) * 16) = pre.v;
#pragma unroll
        for (int ai = 0; ai < 2; ++ai) { const int ch = 2 * ai + wr;
            if (fr == 15) {
#pragma unroll
                for (int mm = 0; mm < 2; ++mm)
#pragma unroll
                    for (int bj = 0; bj < 2; ++bj)
#pragma unroll
                        for (int n = 0; n < 2; ++n) { const f32x4 v = acc[ai][bj][2 + mm][n];
                            if (ch < 3) *(PG8_LAS f32x4*)(xch + ((ch * 2 + mm) * 256 + bj * 128 + cl + 4 * n) * 4) = v;
                            else *(f32x4*)(halo + (size_t)(u.pm * 4 + 2 + mm) * nup + u.pn * 256 + bj * 128 + cl + 4 * n) = v; } }
            if (ch == 0 && fr == 0) {
#pragma unroll
                for (int mm = 0; mm < 2; ++mm)
#pragma unroll
                    for (int bj = 0; bj < 2; ++bj)
#pragma unroll
                        for (int n = 0; n < 2; ++n) *(f32x4*)(halo + (size_t)(u.pm * 4 + mm) * nup + u.pn * 256 + bj * 128 + cl + 4 * n) = acc[0][bj][mm][n]; } }
        asm volatile("s_waitcnt lgkmcnt(0)" ::: "memory"); __builtin_amdgcn_s_barrier(); asm volatile("" ::: "memory");
        u32x2 keep[2][4];
#pragma unroll
        for (int n = 0; n < 2; ++n) {
            f32x4 W[3][2];
#pragma unroll
            for (int bj = 0; bj < 2; ++bj)
#pragma unroll
                for (int k = 0; k < 3; ++k) W[k][bj] = *(const PG8_LAS f32x4*)(pblk + (fq * 16 + (bj * 2 + n) * 4 + k) * 16);
#pragma unroll
            for (int ai = 0; ai < 2; ++ai) { const int ch = 2 * ai + wr; f32x4 hc[2][4];
#pragma unroll
                for (int bj = 0; bj < 2; ++bj) { f32x4 q2 = (f32x4){0.f, 0.f, 0.f, 0.f}, q3 = q2;
                    if (ch > 0 && fr == 0) { q2 = *(const PG8_LAS f32x4*)(xch + (((ch - 1) * 2 + 0) * 256 + bj * 128 + cl + 4 * n) * 4); q3 = *(const PG8_LAS f32x4*)(xch + (((ch - 1) * 2 + 1) * 256 + bj * 128 + cl + 4 * n) * 4); }
                    const f32x4 a0 = acc[ai][bj][0][n], a1 = acc[ai][bj][1][n], a2 = acc[ai][bj][2][n], a3 = acc[ai][bj][3][n]; f32x4 p2, p3;
#pragma unroll
                    for (int j = 0; j < 4; ++j) { p2[j] = shr1(a2[j], q2[j]); p3[j] = shr1(a3[j], q3[j]); }
                    const f32x4 bb = *(const PG8_LAS f32x4*)(pblk + (fq * 16 + (bj * 2 + n) * 4 + 3) * 16);
                    hc[bj][0] = ((bb + p2 * W[0][bj]) + p3 * W[1][bj]) + a0 * W[2][bj];
                    hc[bj][1] = ((bb + p3 * W[0][bj]) + a0 * W[1][bj]) + a1 * W[2][bj];
                    hc[bj][2] = ((bb + a0 * W[0][bj]) + a1 * W[1][bj]) + a2 * W[2][bj];
                    hc[bj][3] = ((bb + a1 * W[0][bj]) + a2 * W[1][bj]) + a3 * W[2][bj]; }
#pragma unroll
                for (int m = 0; m < 4; ++m) { const f32x4 gvp = hc[0][m] * hc[1][m]; f32x4 ex, rc;
#pragma unroll
                    for (int j = 0; j < 4; ++j) ex[j] = __builtin_amdgcn_exp2f(hc[0][m][j]);
                    const f32x4 den = ex + 1.f;
#pragma unroll
                    for (int j = 0; j < 4; ++j) rc[j] = __builtin_amdgcn_rcpf(den[j]);
                    const f32x4 o = gvp * rc;
                    u32x2 wv; wv.x = cvt_pk_bf16(o[0], o[1]); wv.y = cvt_pk_bf16(o[2], o[3]);
                    if (n == 0) keep[ai][m] = wv;
                    else if (!(ch == 0 && fr == 0 && m < 2)) { u32x4 w4; w4.x = keep[ai][m].x; w4.y = keep[ai][m].y; w4.z = wv.x; w4.w = wv.y; *(u32x4*)(A2 + (size_t)(u.pm * BM + ai * HALF + wr * 64 + 4 * fr + m) * dff + f0) = w4; } }
                __builtin_amdgcn_sched_barrier(0); }
            asm volatile("" ::: "memory"); }
    }
};
template <class Epi, class Sched, bool ALIGN_EPI = false, bool SP2 = false>
__device__ __forceinline__ void gemm_phase(PG8_LAS unsigned char* lds, const Gemm g, const Sched& S, const Epi& E) {
    const int tid = threadIdx.x, wid = __builtin_amdgcn_readfirstlane(tid >> 6), lane = tid & 63, wr = wid >> 2, wc = wid & 3, fr = lane & 15, fq = lane >> 4;
    const int K = g.K, nt = K / BK;
    unsigned voffA[2], voffB[2];
#pragma unroll
    for (int i = 0; i < 2; ++i) { int R, C; stage_rc(tid * 16 + i * 8192, R, C); const int Rb = Epi::PERM ? ((R & ~31) + perm32(R & 31)) : R;
        const int Ra = Epi::APERM ? ((R & ~63) + 4 * (R & 15) + ((R >> 4) & 3)) : R; voffA[i] = (unsigned)(Ra * g.lda + C) * 2u; voffB[i] = (unsigned)(Rb * g.ldb + C) * 2u; }
    const size_t kstep = (size_t)(BK * 2);
    const size_t hstepA = (size_t)HALF * g.lda * 2, hstepB = (size_t)HALF * g.ldb * 2;
    const size_t tstepA = 2 * hstepA, tstepB = 2 * hstepB;
    const unsigned ldsw = (unsigned)wid * 1024u;
    const int aoff = lds_byte(wr * 64 + fr, fq * 8), boff = lds_byte(wc * 32 + fr, fq * 8);
#define PG8_SA(b, h) (((b) * 2 + (h)) * HTB)
#define PG8_SB(b, h) ((4 + (b) * 2 + (h)) * HTB)
#define PG8_STAGE(bufoff, gbase, voff) do { _Pragma("unroll") for (int _i = 0; _i < 2; ++_i) \
        __builtin_amdgcn_global_load_lds((const unsigned*)((const char*)(gbase) + (voff)[_i]), (PG8_LAS unsigned*)(lds + (bufoff) + ldsw + _i * 8192), 16, 0, 0); } while (0)
#define PG8_LDA(dst, b, h) do { _Pragma("unroll") for (int m = 0; m < 4; ++m) _Pragma("unroll") for (int k = 0; k < 2; ++k) dst[m][k] = *(const PG8_LAS bf16x8*)(lds + PG8_SA(b, h) + aoff + m * 2048 + k * 1024); } while (0)
#define PG8_LDB(dst, b, h) do { _Pragma("unroll") for (int n = 0; n < 2; ++n) _Pragma("unroll") for (int k = 0; k < 2; ++k) dst[n][k] = *(const PG8_LAS bf16x8*)(lds + PG8_SB(b, h) + boff + n * 2048 + k * 1024); } while (0)
#define PG8_MMA(ai, bj, At, Bt) do { __builtin_amdgcn_s_setprio(1); _Pragma("unroll") for (int m = 0; m < 4; ++m) _Pragma("unroll") for (int n = 0; n < 2; ++n) _Pragma("unroll") for (int k = 0; k < 2; ++k) \
        acc[ai][bj][m][n] = __builtin_amdgcn_mfma_f32_16x16x32_bf16(Bt[n][k], At[m][k], acc[ai][bj][m][n], 0, 0, 0); __builtin_amdgcn_s_setprio(0); } while (0)
#define PG8_WAIT_V(n) asm volatile("s_waitcnt vmcnt(" #n ")" ::: "memory")
#define PG8_WAIT_L(n) asm volatile("s_waitcnt lgkmcnt(" #n ")" ::: "memory")
#define PG8_BAR __builtin_amdgcn_s_barrier()
#define PG8_SCHED __builtin_amdgcn_sched_barrier(0)
    Unit cur, nxt; int ui = 0;
    if (!S.next(0, cur)) return;
    typename Epi::Pre pre; E.preload(cur, pre, wc, lane);
    f32x4 acc[2][2][4][2];
#pragma unroll
    for (int a = 0; a < 2; ++a)
#pragma unroll
        for (int b = 0; b < 2; ++b)
#pragma unroll
            for (int m = 0; m < 4; ++m)
#pragma unroll
                for (int n = 0; n < 2; ++n) acc[a][b][m][n] = (f32x4){0.f, 0.f, 0.f, 0.f};
    bf16x8 At[4][2], B0[2][2], B1[2][2];
    const char* cA = (const char*)g.A + (size_t)cur.pm * tstepA + (g.agrp ? (size_t)(cur.pn / g.agrp) * K * 2 : 0); const char* cB = (const char*)g.Bt + (size_t)cur.pn * tstepB;
    S.a_ready(cur);
    if constexpr (SP2) {
        PG8_STAGE(PG8_SB(0, 0), cB, voffB); PG8_STAGE(PG8_SB(0, 1), cB + hstepB, voffB); PG8_STAGE(PG8_SA(0, 0), cA, voffA); PG8_STAGE(PG8_SA(0, 1), cA + hstepA, voffA);
        if (wr == 1) PG8_BAR;
        PG8_WAIT_V(2); PG8_BAR;
        PG8_STAGE(PG8_SB(1, 0), cB + kstep, voffB); PG8_STAGE(PG8_SA(1, 0), cA + kstep, voffA); PG8_STAGE(PG8_SB(1, 1), cB + hstepB + kstep, voffB);
        PG8_WAIT_V(6); PG8_BAR;
    } else {
        PG8_STAGE(PG8_SB(0, 0), cB, voffB); PG8_STAGE(PG8_SA(0, 0), cA, voffA); PG8_STAGE(PG8_SB(0, 1), cB + hstepB, voffB); PG8_STAGE(PG8_SA(0, 1), cA + hstepA, voffA);
        if (wr == 1) PG8_BAR;
        PG8_WAIT_V(4); PG8_BAR;
        PG8_STAGE(PG8_SB(1, 0), cB + kstep, voffB); PG8_STAGE(PG8_SA(1, 0), cA + kstep, voffA); PG8_STAGE(PG8_SB(1, 1), cB + hstepB + kstep, voffB);
        PG8_WAIT_V(6); PG8_BAR;
    }
    for (;;) {
        const bool has_next = S.next(ui + 1, nxt);
        const char* nA = has_next ? (const char*)g.A + (size_t)nxt.pm * tstepA + (g.agrp ? (size_t)(nxt.pn / g.agrp) * K * 2 : 0) : cA; const char* nB = has_next ? (const char*)g.Bt + (size_t)nxt.pn * tstepB : cB;
        for (int t = 0; t < nt; t += 2) {
            const bool last = (t == nt - 2);
            const char* a1 = cA + (size_t)(t + 1) * kstep;
            const char* a2 = last ? nA : cA + (size_t)(t + 2) * kstep; const char* b2 = last ? nB : cB + (size_t)(t + 2) * kstep;
            const char* a3 = a2 + kstep; const char* b3 = b2 + kstep;
            if (last && has_next) S.a_ready(nxt);
            if constexpr (SP2) {
            PG8_LDB(B0, 0, 0); PG8_LDB(B1, 0, 1); PG8_SCHED; PG8_LDA(At, 0, 0); PG8_STAGE(PG8_SA(1, 1), a1 + hstepA, voffA);
            PG8_WAIT_V(8); PG8_WAIT_L(0); PG8_BAR; PG8_MMA(0, 0, At, B0); PG8_MMA(0, 1, At, B1); PG8_BAR; PG8_SCHED;
            PG8_LDA(At, 0, 1); PG8_STAGE(PG8_SB(0, 0), b2, voffB); PG8_STAGE(PG8_SB(0, 1), b2 + hstepB, voffB); PG8_STAGE(PG8_SA(0, 0), a2, voffA);
            PG8_WAIT_V(8); PG8_WAIT_L(0); PG8_BAR; PG8_MMA(1, 0, At, B0); PG8_MMA(1, 1, At, B1); PG8_BAR; PG8_SCHED;
            PG8_LDB(B0, 1, 0); PG8_LDB(B1, 1, 1); PG8_SCHED; PG8_LDA(At, 1, 0); PG8_STAGE(PG8_SA(0, 1), a2 + hstepA, voffA);
            PG8_WAIT_V(8); PG8_WAIT_L(0); PG8_BAR; PG8_MMA(0, 0, At, B0); PG8_MMA(0, 1, At, B1); PG8_BAR; PG8_SCHED;
            PG8_LDA(At, 1, 1); PG8_STAGE(PG8_SB(1, 0), b3, voffB); PG8_STAGE(PG8_SB(1, 1), b3 + hstepB, voffB); PG8_STAGE(PG8_SA(1, 0), a3, voffA);
            PG8_WAIT_V(8); PG8_WAIT_L(0); PG8_BAR; PG8_MMA(1, 0, At, B0); PG8_MMA(1, 1, At, B1); PG8_BAR; PG8_SCHED;
            } else {
            PG8_LDB(B0, 0, 0); PG8_SCHED; PG8_LDA(At, 0, 0); PG8_STAGE(PG8_SA(1, 1), a1 + hstepA, voffA);
            PG8_WAIT_L(8); PG8_BAR; PG8_WAIT_L(0); PG8_MMA(0, 0, At, B0); PG8_BAR; PG8_SCHED;
            PG8_LDB(B1, 0, 1); PG8_STAGE(PG8_SB(0, 0), b2, voffB);
            PG8_BAR; PG8_WAIT_L(0); PG8_MMA(0, 1, At, B1); PG8_BAR;
            PG8_LDA(At, 0, 1); PG8_STAGE(PG8_SA(0, 0), a2, voffA);
            PG8_BAR; PG8_WAIT_L(0); PG8_MMA(1, 0, At, B0); PG8_BAR; PG8_SCHED;
            PG8_STAGE(PG8_SB(0, 1), b2 + hstepB, voffB);
            PG8_WAIT_V(6); PG8_BAR; PG8_MMA(1, 1, At, B1); PG8_BAR;
            PG8_LDB(B0, 1, 0); PG8_SCHED; PG8_LDA(At, 1, 0); PG8_STAGE(PG8_SA(0, 1), a2 + hstepA, voffA);
            PG8_WAIT_L(8); PG8_BAR; PG8_WAIT_L(0); PG8_MMA(0, 0, At, B0); PG8_BAR; PG8_SCHED;
            PG8_LDB(B1, 1, 1); PG8_STAGE(PG8_SB(1, 0), b3, voffB);
            PG8_BAR; PG8_WAIT_L(0); PG8_MMA(0, 1, At, B1); PG8_BAR;
            PG8_LDA(At, 1, 1); PG8_STAGE(PG8_SA(1, 0), a3, voffA);
            PG8_BAR; PG8_WAIT_L(0); PG8_MMA(1, 0, At, B0); PG8_BAR; PG8_SCHED;
            PG8_STAGE(PG8_SB(1, 1), b3 + hstepB, voffB);
            PG8_WAIT_V(6); PG8_BAR; PG8_MMA(1, 1, At, B1); PG8_BAR;
            }
        }
        if constexpr (ALIGN_EPI) { if (wr == 0) PG8_BAR; }
        if constexpr (!Epi::AFTER_DRAIN) { E(acc, cur, wr, wc, fr, fq, pre); S.done(cur); }
        if (!has_next) break;
#pragma unroll
        for (int a = 0; a < 2; ++a)
#pragma unroll
            for (int b = 0; b < 2; ++b)
#pragma unroll
                for (int m = 0; m < 4; ++m)
#pragma unroll
                    for (int n = 0; n < 2; ++n) acc[a][b][m][n] = (f32x4){0.f, 0.f, 0.f, 0.f};
        cur = nxt; cA = nA; cB = nB; ++ui; E.preload(cur, pre, wc, lane);
        if constexpr (ALIGN_EPI) { if (wr == 1) PG8_BAR; }
    }
    PG8_WAIT_V(0);
    if constexpr (!ALIGN_EPI) { if (wr == 0) PG8_BAR; }
    PG8_BAR;
    if constexpr (Epi::AFTER_DRAIN) { E.fused(acc, cur, wr, wc, fr, fq, lds, wid, lane); S.done(cur); }
#undef PG8_SA
#undef PG8_SB
#undef PG8_STAGE
#undef PG8_LDA
#undef PG8_LDB
#undef PG8_MMA
#undef PG8_WAIT_V
#undef PG8_WAIT_L
#undef PG8_BAR
#undef PG8_SCHED
}
}

#ifndef PG8_SP2
#define PG8_SP2 true
#endif
#ifndef PG8_ALIGN
#define PG8_ALIGN true
#endif
constexpr int NWAVES = 8;
#ifndef MK_PER_PHASE
#define MK_PER_PHASE 0
#endif
constexpr int N_PHASES = 17;

constexpr int BATCH = 8, T = 2048, D = 4096, M = BATCH * T, HD = 128;
constexpr int IN_DIM = 11312, LDH = 11520;
constexpr int C_QA = 0, C_KC = 2048, C_VC = 2560, C_KS = 3072, C_VS = 3584, C_KW = 4096, C_VW = 4608, C_QB = 5120, C_KB = 7168, C_VB = 9216, C_GATE = 11264;
constexpr int DFF = 11008, NUP = 2 * DFF;
constexpr float LN_EPS = 1e-5f, ALPHA = 1.41421356237309515f;

constexpr size_t MiB = 1u << 20;
constexpr size_t WS_CTL = 0, CTL_ZERO_BYTES = 128 * 1024;
constexpr size_t WS_COS = 1 * MiB, WS_SIN = WS_COS + 512 * 1024;
constexpr size_t WS_CK = 2 * MiB, WS_CV = WS_CK + 1024;
constexpr size_t WS_WCKT = 3 * MiB, WS_WCVT = 4 * MiB;
constexpr size_t WS_KC = 5 * MiB, WS_VC = 6 * MiB;
constexpr size_t WS_WPOOLT = 8 * MiB, WS_WOUTT = 16 * MiB, WS_WINT = 48 * MiB, WS_WUP0T = 138 * MiB, WS_WUP1T = 310 * MiB, WS_WDN0T = 482 * MiB, WS_WDN1T = 568 * MiB;
constexpr size_t WS_XB = 654 * MiB;
constexpr size_t WS_X1 = 782 * MiB;
constexpr size_t WS_Y = 1038 * MiB;
constexpr size_t WS_A2 = 1294 * MiB;
constexpr size_t WS_HQ = 1638 * MiB;
constexpr size_t WS_OACC = 1998 * MiB;
constexpr size_t WS_OC = 2126 * MiB;
constexpr size_t WS_H = 1638 * MiB;
constexpr size_t WS_COLP = 2326 * MiB;
constexpr size_t WS_COLS = 2350 * MiB;
constexpr size_t WS_RPART = 2352 * MiB;
constexpr size_t WS_STATS = 2360 * MiB;
constexpr size_t WS_END = 2362 * MiB;
static_assert(WS_WINT + (size_t)LDH * D * 2 <= WS_WUP0T && WS_WUP0T + (size_t)NUP * D * 2 <= WS_WUP1T && WS_WUP1T + (size_t)NUP * D * 2 <= WS_WDN0T && WS_WDN0T + (size_t)D * DFF * 2 <= WS_WDN1T && WS_WDN1T + (size_t)D * DFF * 2 <= WS_XB, "ws map 1");
static_assert(WS_XB + (size_t)M * D * 2 <= WS_X1 && WS_X1 + (size_t)M * D * 4 <= WS_Y && WS_Y + (size_t)M * D * 4 <= WS_A2 && WS_A2 + (size_t)M * DFF * 2 <= WS_HQ && WS_HQ + (size_t)M * LDH * 2 <= WS_OACC && WS_OACC + (size_t)M * 2048 * 4 <= WS_OC && WS_OC + (size_t)M * D * 2 <= WS_COLP && WS_H + (size_t)(M / 256) * 4 * NUP * 4 <= WS_OACC && WS_COLP + (size_t)2 * 64 * NUP * 8 <= WS_COLS && WS_COLS + (size_t)2 * NUP * 8 <= WS_RPART && WS_RPART + (size_t)M * 64 * 8 <= WS_STATS && WS_STATS + (size_t)M * 8 <= WS_END, "ws map 2");
constexpr int CW_BAR = 4096;
constexpr int CW_QNSA = 8192, CW_QSB = 8192 + 1024;

constexpr int RING_OFF = 0, RING_BYTES = 131072;
constexpr int MISC_OFF = RING_BYTES;
constexpr int XCH_OFF = RING_BYTES + 256;
constexpr int LDS_BYTES = 147456;

#define LAS __attribute__((address_space(3)))
typedef unsigned short bf16;
typedef unsigned v4u __attribute__((ext_vector_type(4)));
typedef unsigned v2u __attribute__((ext_vector_type(2)));
typedef float f32x4 __attribute__((ext_vector_type(4)));
typedef float f32x16 __attribute__((ext_vector_type(16)));
typedef short bf16x8 __attribute__((ext_vector_type(8)));
typedef short s16x4 __attribute__((ext_vector_type(4)));
typedef _Float16 h8 __attribute__((ext_vector_type(8)));
typedef _Float16 h4 __attribute__((ext_vector_type(4)));
__device__ __forceinline__ f32x4 ld4h(const _Float16* p) { const h4 y = *(const h4*)p; return (f32x4){(float)y[0], (float)y[1], (float)y[2], (float)y[3]}; }
__device__ __forceinline__ void load_row_h(const _Float16* yrow, int lane, f32x4 (&v)[16]) {
#pragma unroll
    for (int j = 0; j < 8; ++j) { const h8 y = *((const h8*)yrow + lane + 64 * j); v[2 * j] = (f32x4){(float)y[0], (float)y[1], (float)y[2], (float)y[3]}; v[2 * j + 1] = (f32x4){(float)y[4], (float)y[5], (float)y[6], (float)y[7]}; }
}
#define LDS_WAIT() asm volatile("s_waitcnt lgkmcnt(0)" ::: "memory")
#define VM_WAIT() asm volatile("s_waitcnt vmcnt(0)" ::: "memory")
__device__ __forceinline__ unsigned cvtpk(float lo, float hi) { unsigned r; asm volatile("v_cvt_pk_bf16_f32 %0, %1, %2" : "=v"(r) : "v"(lo), "v"(hi)); return r; }
__device__ __forceinline__ float bf2f(unsigned short b) { return __uint_as_float(((unsigned)b) << 16); }
__device__ __forceinline__ float wave_sum(float v) {
#pragma unroll
    for (int o = 1; o < 64; o <<= 1) v += __shfl_xor(v, o);
    return v;
}
#define XB_TMO      128
#define XB_XCNT(j)  (256  + 64 * (j))
#define XB_XSUB(j)  (1280 + 64 * (j))
#define XB_XGEN(j)  (2304 + 64 * (j))
#define XB_TOP      3328
#define XB_TOPGEN   3392
#define XCD_BAR_WORDS 3456
#define XB_SPIN_CAP (1u << 18)

__device__ __forceinline__ unsigned xb_ld(unsigned* p)              { return __hip_atomic_load(p, __ATOMIC_RELAXED, __HIP_MEMORY_SCOPE_AGENT); }
__device__ __forceinline__ unsigned xb_add(unsigned* p, unsigned v) { return __hip_atomic_fetch_add(p, v, __ATOMIC_RELAXED, __HIP_MEMORY_SCOPE_AGENT); }
__device__ __forceinline__ unsigned xb_xcc_id() { return (unsigned)__builtin_amdgcn_s_getreg((3 << 11) | 20) & 0xFu; }
#define XB_SPIN(cond, bar) do { unsigned _sp = 0; while (cond) { __builtin_amdgcn_s_sleep(1); \
    if ((++_sp & 255u) == 0u) { if (xb_ld(&(bar)[XB_TMO])) break; if (_sp > XB_SPIN_CAP) { atomicAdd(&(bar)[XB_TMO], 1u); break; } } } } while (0)

struct XcdBarrier {
    unsigned* bar; unsigned x;
    volatile LAS unsigned* st;
};

__device__ __forceinline__ XcdBarrier xcd_barrier_post(unsigned* bar, volatile LAS unsigned* st) {
    XcdBarrier b; b.bar = bar; b.x = xb_xcc_id(); b.st = st;
    if (threadIdx.x == 0) (void)xb_add(&bar[XB_XCNT(b.x)], 1u);
    return b;
}
__device__ __forceinline__ void xcd_barrier_complete(unsigned* bar, unsigned x, unsigned& nloc, unsigned& nx) {
    const unsigned G = gridDim.x * gridDim.y * gridDim.z;
    unsigned sum, cnt, mine, sp = 0u;
    for (;;) {
        sum = 0u; cnt = 0u; mine = 0u;
#pragma unroll
        for (unsigned j = 0; j < 16; ++j) { const unsigned c = xb_ld(&bar[XB_XCNT(j)]); sum += c; cnt += (c > 0u) ? 1u : 0u; mine = (j == x) ? c : mine; }
        if (sum == G) break;
        __builtin_amdgcn_s_sleep(1);
        if ((++sp & 255u) == 0u) { if (xb_ld(&bar[XB_TMO])) break; if (sp > XB_SPIN_CAP) { atomicAdd(&bar[XB_TMO], 1u); break; } }
    }
    nloc = mine > 0u ? mine : 1u; nx = cnt > 0u ? cnt : 1u;
}

__device__ __forceinline__ void xcd_barrier(const XcdBarrier& b) {
    asm volatile("s_waitcnt vmcnt(0)" ::: "memory");
    __syncthreads();
    if (threadIdx.x == 0) {
        unsigned* bar = b.bar;
        __builtin_amdgcn_s_waitcnt(0);
        unsigned nloc = b.st[0], nx = b.st[1];
        if (nloc == 0u) { xcd_barrier_complete(bar, b.x, nloc, nx); b.st[0] = nloc; b.st[1] = nx; }
        const unsigned old = xb_add(&bar[XB_XSUB(b.x)], 1u);
        const unsigned gen = old / nloc;
        if (old + 1u == (gen + 1u) * nloc) {
            __builtin_amdgcn_fence(__ATOMIC_RELEASE, "agent");
            asm volatile("s_waitcnt vmcnt(0)" ::: "memory");
            const unsigned og = xb_add(&bar[XB_TOP], 1u);
            const unsigned tg = og / nx;
            if (og + 1u == (tg + 1u) * nx) xb_add(&bar[XB_TOPGEN], 1u);
            else XB_SPIN(xb_ld(&bar[XB_TOPGEN]) == tg, bar);
            __builtin_amdgcn_fence(__ATOMIC_ACQUIRE, "agent");
            xb_add(&bar[XB_XGEN(b.x)], 1u);
            asm volatile("s_waitcnt vmcnt(0)" ::: "memory");
        } else {
            XB_SPIN(xb_ld(&bar[XB_XGEN(b.x)]) == gen, bar);
            __builtin_amdgcn_fence(__ATOMIC_ACQUIRE, "agent");
            asm volatile("s_waitcnt vmcnt(0)" ::: "memory");
        }
    }
    __syncthreads();
}

__device__ __forceinline__ int inproj_phys(int L) {
    int P = L < 5120 ? L : (L < 5168 ? C_GATE + (L - 5120) : L - 48);
    const int hb = P >> 7;
    if ((hb < 16) || (hb >= 24 && hb < 28) || (hb >= 32 && hb < 36)) { const int d = P & 127, n = d >> 6, q = (d >> 2) & 15, j = d & 3; P = (hb << 7) + 8 * q + 4 * n + j; }
    return P;
}
__device__ __forceinline__ int up_phys(int L) { const int bj = L >= DFF ? 1 : 0, f = L - bj * DFF; return (f >> 7) * 256 + bj * 128 + (f & 127); }

struct TrItem { const float* W; bf16* WT; const float* lg; const float* lb; float* colp; int K, N, row_off, map, item; };
__device__ __forceinline__ void tr_load(const TrItem& t, f32x4 (&v)[8], int lane) {
    const int nblk = (t.N + 31) / 32, kb = t.item / nblk, nb = t.item % nblk, k0 = 64 * kb, n0 = 32 * nb, r8 = lane >> 3, c4 = (lane & 7) * 4; const bool inb = n0 + c4 < t.N;
#pragma unroll
    for (int i = 0; i < 8; ++i) v[i] = inb ? *(const f32x4*)(t.W + (size_t)(k0 + 8 * i + r8) * t.N + n0 + c4) : (f32x4){0.f, 0.f, 0.f, 0.f};
}
__device__ __forceinline__ void tr_store(const TrItem& t, const f32x4 (&v)[8], LAS float* scr, int lane) {
    const int K = t.K, N = t.N, nblk = (N + 31) / 32, kb = t.item / nblk, nb = t.item % nblk, k0 = 64 * kb, n0 = 32 * nb, r8 = lane >> 3, c4 = (lane & 7) * 4;
#pragma unroll
    for (int i = 0; i < 8; ++i) { LAS float* d = scr + (8 * i + r8) * 33 + c4; d[0] = v[i][0]; d[1] = v[i][1]; d[2] = v[i][2]; d[3] = v[i][3]; }
    LDS_WAIT(); asm volatile("" ::: "memory");
    const int c = lane & 7;
    f32x4 g0, g1, b0, b1;
    if (t.map == 2) { g0 = *(const f32x4*)(t.lg + k0 + 8 * c); g1 = *(const f32x4*)(t.lg + k0 + 8 * c + 4); b0 = *(const f32x4*)(t.lb + k0 + 8 * c); b1 = *(const f32x4*)(t.lb + k0 + 8 * c + 4); }
#pragma unroll
    for (int j = 0; j < 4; ++j) { const int n = (lane >> 3) + 8 * j; const LAS float* s = scr + (8 * c) * 33 + n;
        float wv[8];
#pragma unroll
        for (int i = 0; i < 8; ++i) wv[i] = s[i * 33];
        v4u o;
        if (t.map == 2) {
            float bs = ((wv[0] * b0[0] + wv[1] * b0[1]) + (wv[2] * b0[2] + wv[3] * b0[3])) + ((wv[4] * b1[0] + wv[5] * b1[1]) + (wv[6] * b1[2] + wv[7] * b1[3]));
            o.x = cvtpk(wv[0] * g0[0], wv[1] * g0[1]); o.y = cvtpk(wv[2] * g0[2], wv[3] * g0[3]); o.z = cvtpk(wv[4] * g1[0], wv[5] * g1[1]); o.w = cvtpk(wv[6] * g1[2], wv[7] * g1[3]);
            float cs = 0.f;
#pragma unroll
            for (int i = 0; i < 4; ++i) cs += __uint_as_float(o[i] << 16) + __uint_as_float(o[i] & 0xffff0000u);
            cs += __shfl_xor(cs, 1); cs += __shfl_xor(cs, 2); cs += __shfl_xor(cs, 4); bs += __shfl_xor(bs, 1); bs += __shfl_xor(bs, 2); bs += __shfl_xor(bs, 4);
            if (c == 0 && n0 + n < N) { float* cp = t.colp + ((size_t)kb * N + up_phys(n0 + n)) * 2; cp[0] = cs; cp[1] = bs; }
        } else { o.x = cvtpk(wv[0], wv[1]); o.y = cvtpk(wv[2], wv[3]); o.z = cvtpk(wv[4], wv[5]); o.w = cvtpk(wv[6], wv[7]); }
        if (n0 + n < N) { const int row = t.map == 1 ? inproj_phys(n0 + n) : (t.map == 2 ? up_phys(n0 + n) : t.row_off + n0 + n);
            *(v4u*)(t.WT + (size_t)row * K + k0 + 8 * c) = o; } }
    LDS_WAIT(); asm volatile("" ::: "memory");
}
__device__ __forceinline__ void sincos_d(double a, double& s, double& c) {
    const double q = rint(a * 0.63661977236758134308);
    double r = fma(-q, 1.57079632679489655800, a); r = fma(-q, 6.12323399573676603587e-17, r);
    const double r2 = r * r;
    const double sp = r * (1.0 + r2 * (-1.0 / 6.0 + r2 * (1.0 / 120.0 + r2 * (-1.0 / 5040.0 + r2 * (1.0 / 362880.0 + r2 * (-1.0 / 39916800.0 + r2 * (1.0 / 6227020800.0 + r2 * (-1.0 / 1307674368000.0))))))));
    const double cp = 1.0 + r2 * (-0.5 + r2 * (1.0 / 24.0 + r2 * (-1.0 / 720.0 + r2 * (1.0 / 40320.0 + r2 * (-1.0 / 3628800.0 + r2 * (1.0 / 479001600.0 + r2 * (-1.0 / 87178291200.0 + r2 * (1.0 / 20922789888000.0))))))));
    const int qi = (int)((long long)q & 3);
    s = (qi == 0) ? sp : (qi == 1) ? cp : (qi == 2) ? -sp : -cp;
    c = (qi == 0) ? cp : (qi == 1) ? -sp : (qi == 2) ? -cp : sp;
}
struct Ptrs {
    const float *x, *w_in, *w_out, *cmp_wk, *cmp_wv, *pe_k, *pe_v, *pool_w, *pool_scale, *w_up, *conv_w, *conv_b, *w_down, *ln_mix_g, *ln_mix_b, *ln_ffn_g, *ln_ffn_b;
    float* out; unsigned char* ws;
};
__device__ __forceinline__ void p0_prologue(const Ptrs& P, LAS unsigned char* lds, int gw, int NGW, int wave, int lane) {
    LAS float* scr = (LAS float*)(lds + RING_OFF + wave * 16384);
    unsigned char* ws = P.ws;
    constexpr int I_IN = (D / 64) * ((IN_DIM + 31) / 32), I_OUT = (D / 64) * (D / 32), I_UP = (D / 64) * (NUP / 32), I_DN = (DFF / 64) * (D / 32), I_POOL = (1024 / 64) * (1024 / 32), I_CMP = (4096 / 64) * (128 / 32);
    constexpr int NITEMS = I_IN + I_OUT + 2 * I_UP + 2 * I_DN + 4 * I_POOL + 2 * I_CMP;
    auto decode = [&](int it) -> TrItem { TrItem t; t.lg = nullptr; t.lb = nullptr; t.colp = nullptr; t.row_off = 0; t.map = 0; int r = it;
        if (r < I_UP) { t.W = P.w_up; t.WT = (bf16*)(ws + WS_WUP0T); t.K = D; t.N = NUP; t.map = 2; t.lg = P.ln_mix_g; t.lb = P.ln_mix_b; t.colp = (float*)(ws + WS_COLP); t.item = r; return t; } r -= I_UP;
        if (r < I_UP) { t.W = P.w_up + (size_t)D * NUP; t.WT = (bf16*)(ws + WS_WUP1T); t.K = D; t.N = NUP; t.map = 2; t.lg = P.ln_mix_g + D; t.lb = P.ln_mix_b + D; t.colp = (float*)(ws + WS_COLP) + (size_t)64 * NUP * 2; t.item = r; return t; } r -= I_UP;
        if (r < I_IN) { t.W = P.w_in; t.WT = (bf16*)(ws + WS_WINT); t.K = D; t.N = IN_DIM; t.map = 1; t.item = r; return t; } r -= I_IN;
        if (r < I_DN) { t.W = P.w_down; t.WT = (bf16*)(ws + WS_WDN0T); t.K = DFF; t.N = D; t.item = r; return t; } r -= I_DN;
        if (r < I_DN) { t.W = P.w_down + (size_t)DFF * D; t.WT = (bf16*)(ws + WS_WDN1T); t.K = DFF; t.N = D; t.item = r; return t; } r -= I_DN;
        if (r < I_OUT) { t.W = P.w_out; t.WT = (bf16*)(ws + WS_WOUTT); t.K = D; t.N = D; t.item = r; return t; } r -= I_OUT;
        if (r < 4 * I_POOL) { const int g = r / I_POOL; t.W = P.pool_w + (size_t)g * 1024 * 1024; t.WT = (bf16*)(ws + WS_WPOOLT); t.K = 1024; t.N = 1024; t.row_off = g * 1024; t.item = r % I_POOL; return t; } r -= 4 * I_POOL;
        if (r < I_CMP) { t.W = P.cmp_wk; t.WT = (bf16*)(ws + WS_WCKT); t.K = 4096; t.N = 128; t.item = r; return t; } r -= I_CMP;
        t.W = P.cmp_wv; t.WT = (bf16*)(ws + WS_WCVT); t.K = 4096; t.N = 128; t.item = r; return t; };
    if (gw < NITEMS) { TrItem cur = decode(gw); f32x4 va[8], vb[8]; tr_load(cur, va, lane);
        for (int it = gw; it < NITEMS; it += 2 * NGW) {
            const bool h1 = it + NGW < NITEMS; TrItem n1 = cur; if (h1) { n1 = decode(it + NGW); tr_load(n1, vb, lane); }
            tr_store(cur, va, scr, lane);
            if (!h1) break;
            const bool h2 = it + 2 * NGW < NITEMS; if (h2) { cur = decode(it + 2 * NGW); tr_load(cur, va, lane); }
            tr_store(n1, vb, scr, lane);
            if (!h2) break; } }
    { bf16* xb = (bf16*)(ws + WS_XB);
      for (int i = gw; i < M * D / 2048; i += NGW) { f32x4 a[4], b[4];
#pragma unroll
          for (int q = 0; q < 4; ++q) { const size_t e = (size_t)i * 2048 + q * 512 + lane * 8; a[q] = *(const f32x4*)(P.x + e); b[q] = *(const f32x4*)(P.x + e + 4); }
#pragma unroll
          for (int q = 0; q < 4; ++q) { const size_t e = (size_t)i * 2048 + q * 512 + lane * 8; v4u o; o.x = cvtpk(a[q][0], a[q][1]); o.y = cvtpk(a[q][2], a[q][3]); o.z = cvtpk(b[q][0], b[q][1]); o.w = cvtpk(b[q][2], b[q][3]); *(v4u*)(xb + e) = o; } } }
    { float* ct = (float*)(ws + WS_COS); float* st = (float*)(ws + WS_SIN);
      for (int i = gw * 64 + lane; i < T * 64; i += NGW * 64) { const int pos = i >> 6, fi = i & 63; double pw = 1.0; for (int k = 0; k < fi; ++k) pw *= 1.1547819846894583;
          double s, c; sincos_d((double)pos / pw, s, c); ct[i] = (float)c; st[i] = (float)s; } }
    for (int it = gw; it < 256; it += NGW) { const int kv = it >> 7, e = it & 127; const float* pe = kv ? P.pe_v : P.pe_k; const float* W = kv ? P.cmp_wv : P.cmp_wk; float s = 0.f;
        for (int kk = lane; kk < 4096; kk += 64) s += pe[kk] * W[(size_t)kk * 128 + e];
        s = wave_sum(s); if (lane == 0) ((float*)(ws + (kv ? WS_CV : WS_CK)))[e] = s; }
    { v4u* z = (v4u*)((bf16*)(ws + WS_WINT) + (size_t)IN_DIM * D); const int n16 = (LDH - IN_DIM) * D * 2 / 16;
      for (int i = gw * 64 + lane; i < n16; i += NGW * 64) z[i] = (v4u){0u, 0u, 0u, 0u}; }
}

__device__ __forceinline__ void ln_rows(const _Float16* Y, const float* g, const float* b, float* Xo, bf16* Xb, int gw, int NGW, int lane) {
    f32x4 gg[16], bb[16];
#pragma unroll
    for (int j = 0; j < 16; ++j) { const int c = 512 * (j >> 1) + 8 * lane + 4 * (j & 1); gg[j] = *(const f32x4*)(g + c); bb[j] = *(const f32x4*)(b + c); }
    for (int m = gw; m < M; m += NGW) {
        f32x4 v[16]; load_row_h(Y + (size_t)m * D, lane, v); float s = 0.f;
#pragma unroll
        for (int j = 0; j < 16; ++j) s += (v[j].x + v[j].y) + (v[j].z + v[j].w);
        const float mean = wave_sum(s) * (1.f / D); float s2 = 0.f;
#pragma unroll
        for (int j = 0; j < 16; ++j) { v[j] = v[j] - mean; s2 += (v[j].x * v[j].x + v[j].y * v[j].y) + (v[j].z * v[j].z + v[j].w * v[j].w); }
        const float rstd = 1.f / sqrtf(wave_sum(s2) * (1.f / D) + LN_EPS);
#pragma unroll
        for (int j = 0; j < 16; ++j) { const int c = 512 * (j >> 1) + 8 * lane + 4 * (j & 1); const f32x4 o = v[j] * rstd * gg[j] + bb[j];
            if (Xo) *(f32x4*)(Xo + (size_t)m * D + c) = o;
            if (Xb) { v2u w; w.x = cvtpk(o[0], o[1]); w.y = cvtpk(o[2], o[3]); *(v2u*)(Xb + (size_t)m * D + c) = w; } }
    }
}

__device__ __forceinline__ void ln_light(const _Float16* Y, float* stats, bf16* ZB, int gw, int NGW, int lane) {
    for (int m = gw; m < M; m += NGW) {
        f32x4 v[16]; load_row_h(Y + (size_t)m * D, lane, v); float s = 0.f;
#pragma unroll
        for (int j = 0; j < 16; ++j) s += (v[j].x + v[j].y) + (v[j].z + v[j].w);
        const float mean = wave_sum(s) * (1.f / D); float s2 = 0.f;
#pragma unroll
        for (int j = 0; j < 16; ++j) { v[j] = v[j] - mean; s2 += (v[j].x * v[j].x + v[j].y * v[j].y) + (v[j].z * v[j].z + v[j].w * v[j].w); }
        const float rstd = 1.f / sqrtf(wave_sum(s2) * (1.f / D) + LN_EPS);
        if (lane == 0) { stats[2 * m] = mean; stats[2 * m + 1] = rstd; }
        if (ZB) {
#pragma unroll
            for (int j = 0; j < 8; ++j) { const f32x4 a = v[2 * j] * rstd, c = v[2 * j + 1] * rstd; v4u w; w.x = cvtpk(a[0], a[1]); w.y = cvtpk(a[2], a[3]); w.z = cvtpk(c[0], c[1]); w.w = cvtpk(c[2], c[3]);
                *((v4u*)(ZB + (size_t)m * D) + lane + 64 * j) = w; } }
    }
}
__device__ __forceinline__ void finalize_cols(const float* colp, float* cols, float* pk, const float* cw, const float* cb, int gw, int NGW, int lane) {
    for (int i = gw * 64 + lane; i < 2 * NUP; i += NGW * 64) { const int layer = i / NUP, n = i % NUP; const float* cp = colp + ((size_t)layer * 64 * NUP + n) * 2; float cs = 0.f, bs = 0.f;
        for (int kb = 0; kb < 64; ++kb) { cs += cp[(size_t)kb * NUP * 2]; bs += cp[(size_t)kb * NUP * 2 + 1]; }
        const int L = ((n >> 7) & 1) * DFF + (n >> 8) * 128 + (n & 127); const float* w = cw + (size_t)layer * 3 * NUP + L;
        const float cbf = cb[(size_t)layer * NUP + L] + bs * ((w[0] + w[NUP]) + w[2 * NUP]);
        float* c3 = cols + (size_t)layer * 3 * NUP; c3[n] = cs; c3[NUP + n] = bs; c3[2 * NUP + n] = cbf;
        { const int cl = n & 127, bj = (n >> 7) & 1; const float sc = bj ? -0.6931471805599453f : -1.4426950408889634f;
          float* pp = pk + (size_t)layer * (NUP / 256) * 4 * 64 * 4 + ((size_t)(((n >> 8) * 4 + (cl >> 5)) * 64 + ((cl >> 3) & 3) * 16 + (bj * 2 + ((cl >> 2) & 1)) * 4)) * 4 + (cl & 3);
          pp[0] = w[0] * sc; pp[4] = w[NUP] * sc; pp[8] = w[2 * NUP] * sc; pp[12] = cbf * sc; } }
}

__device__ __forceinline__ void pool_diff(const _Float16* Y, float* stats, const float* g, bf16* Db, LAS float* st, int G, int tid, int wave, int lane) {
    for (int task = blockIdx.x; task < M / 32; task += G) {
        const int m0 = task * 32, t0 = m0 & (T - 1), nh = t0 < 15 ? t0 : 15;
        __syncthreads();
        for (int r0 = wave; r0 < 32 + nh; r0 += 3 * NWAVES) {
            h8 raw[3][8];
#pragma unroll
            for (int q = 0; q < 3; ++q) { const int r = r0 + q * NWAVES; if (r < 32 + nh) { const h8* yr = (const h8*)(Y + (size_t)(m0 - nh + r) * D) + lane;
#pragma unroll
                for (int j = 0; j < 8; ++j) raw[q][j] = yr[64 * j]; } }
#pragma unroll
            for (int q = 0; q < 3; ++q) { const int r = r0 + q * NWAVES; if (r < 32 + nh) { const int m = m0 - nh + r; f32x4 v[16]; float s = 0.f;
#pragma unroll
                for (int j = 0; j < 8; ++j) { const h8 y = raw[q][j]; v[2 * j] = (f32x4){(float)y[0], (float)y[1], (float)y[2], (float)y[3]}; v[2 * j + 1] = (f32x4){(float)y[4], (float)y[5], (float)y[6], (float)y[7]}; }
#pragma unroll
                for (int j = 0; j < 16; ++j) s += (v[j].x + v[j].y) + (v[j].z + v[j].w);
                const float mean = wave_sum(s) * (1.f / D); float s2 = 0.f;
#pragma unroll
                for (int j = 0; j < 16; ++j) { v[j] = v[j] - mean; s2 += (v[j].x * v[j].x + v[j].y * v[j].y) + (v[j].z * v[j].z + v[j].w * v[j].w); }
                const float rstd = 1.f / sqrtf(wave_sum(s2) * (1.f / D) + LN_EPS);
                if (lane == 0) { st[2 * r] = mean; st[2 * r + 1] = rstd; if (r >= nh) { stats[2 * m] = mean; stats[2 * m + 1] = rstd; } } } } }
        __syncthreads();
        const LAS float* sc = st + 2 * nh;
        for (int ch = 0; ch < 2; ++ch) { const int c = 4 * (ch * 512 + tid), w = 2 << (c >> 10);
            const f32x4 gg = *(const f32x4*)(g + c); const f32x4 zero = (f32x4){0.f, 0.f, 0.f, 0.f};
            auto ldb = [&](int rb, h4 (&re)[8], h4 (&rl)[8]) {
#pragma unroll
                for (int j = 0; j < 8; ++j) { const int r = rb * 8 + j; re[j] = *(const h4*)(Y + (size_t)(m0 + r) * D + c);
                    const bool ok = t0 + r - w + 1 >= 0; const int kl = ok ? r - w + 1 : r; rl[j] = *(const h4*)(Y + (size_t)(m0 + kl) * D + c); } };
            h4 reA[8], rlA[8], reB[8], rlB[8];
            ldb(0, reA, rlA);
            f32x4 sum = zero;
            { f32x4 pz[15];
#pragma unroll
              for (int i = 1; i < 16; ++i) { const bool ok = i < w && t0 - i >= 0; const int k = ok ? -i : 0; const float mu = sc[2 * k], rs = sc[2 * k + 1];
                  const f32x4 yv = ld4h(Y + (size_t)(m0 + k) * D + c);
                  pz[i - 1] = ok ? (yv - mu) * rs : zero; }
#pragma unroll
              for (int i = 0; i < 15; ++i) sum += pz[i]; }
            auto run = [&](int rb, const h4 (&re)[8], const h4 (&rl)[8]) {
#pragma unroll
                for (int j = 0; j < 8; ++j) { const int r = rb * 8 + j, t = t0 + r; const float mu = sc[2 * r], rs = sc[2 * r + 1];
                    const f32x4 ze = ((f32x4){(float)re[j][0], (float)re[j][1], (float)re[j][2], (float)re[j][3]} - mu) * rs;
                    const bool ok = t - w + 1 >= 0; const int kl = ok ? r - w + 1 : r; const float mu2 = sc[2 * kl], rs2 = sc[2 * kl + 1];
                    const f32x4 zl = ok ? ((f32x4){(float)rl[j][0], (float)rl[j][1], (float)rl[j][2], (float)rl[j][3]} - mu2) * rs2 : zero;
                    sum += ze;
                    const float icnt = __builtin_amdgcn_rcpf((float)(t + 1 < w ? t + 1 : w)); const f32x4 d = (sum * icnt - ze) * gg;
                    v2u o; o.x = cvtpk(d[0], d[1]); o.y = cvtpk(d[2], d[3]); *(v2u*)(Db + (size_t)(m0 + r) * D + c) = o;
                    sum -= zl; } };
            ldb(1, reB, rlB); run(0, reA, rlA);
            ldb(2, reA, rlA); run(1, reB, rlB);
            ldb(3, reB, rlB); run(2, reA, rlA);
            run(3, reB, rlB); }
    }
}

__device__ __forceinline__ void conv_fix(const float* halo, const float* cols, const float* cw, const float* cb, bf16* A2, int G, int tid) {
    constexpr int NF8 = DFF / 8, NTASK = (M / 256) * NF8;
    for (int id = blockIdx.x * 512 + tid; id < NTASK; id += G * 512) {
        const int pm = id / NF8, fi = id % NF8, f = fi * 8, Pc = (f >> 7) * 256 + (f & 127); const bool first = (pm & 7) == 0;
        float o0[8], o1[8];
#pragma unroll
        for (int hv = 0; hv < 2; ++hv)
#pragma unroll
            for (int q = 0; q < 2; ++q) { const int pc = Pc + hv * 128 + 4 * q, lc = hv * DFF + f + 4 * q;
                const f32x4 z = (f32x4){0.f, 0.f, 0.f, 0.f};
                const f32x4 bw = *(const f32x4*)(cols + NUP + pc);
                const f32x4 p2 = first ? z : *(const f32x4*)(halo + (size_t)((pm - 1) * 4 + 2) * NUP + pc) + bw, p3 = first ? z : *(const f32x4*)(halo + (size_t)((pm - 1) * 4 + 3) * NUP + pc) + bw;
                const f32x4 h0 = *(const f32x4*)(halo + (size_t)(pm * 4 + 0) * NUP + pc) + bw, h1 = *(const f32x4*)(halo + (size_t)(pm * 4 + 1) * NUP + pc) + bw;
                const f32x4 w0 = *(const f32x4*)(cw + lc), w1 = *(const f32x4*)(cw + NUP + lc), w2 = *(const f32x4*)(cw + 2 * NUP + lc), bb = *(const f32x4*)(cb + lc);
                const f32x4 r0 = ((bb + p2 * w0) + p3 * w1) + h0 * w2, r1 = ((bb + p3 * w0) + h0 * w1) + h1 * w2;
#pragma unroll
                for (int j = 0; j < 4; ++j) { if (hv == 0) { o0[4 * q + j] = r0[j] / (1.f + __expf(-r0[j])); o1[4 * q + j] = r1[j] / (1.f + __expf(-r1[j])); } else { o0[4 * q + j] *= r0[j]; o1[4 * q + j] *= r1[j]; } } }
        v4u a, b; a.x = cvtpk(o0[0], o0[1]); a.y = cvtpk(o0[2], o0[3]); a.z = cvtpk(o0[4], o0[5]); a.w = cvtpk(o0[6], o0[7]); b.x = cvtpk(o1[0], o1[1]); b.y = cvtpk(o1[2], o1[3]); b.z = cvtpk(o1[4], o1[5]); b.w = cvtpk(o1[6], o1[7]);
        *(v4u*)(A2 + (size_t)(pm * 256) * DFF + f) = a; *(v4u*)(A2 + (size_t)(pm * 256 + 1) * DFF + f) = b;
    }
}

__device__ __forceinline__ void compress_phase(const Ptrs& P, LAS unsigned char* lds, int gw, int NGW, int wave, int lane) {
    unsigned char* ws = P.ws; const bf16* HQ = (const bf16*)(ws + WS_HQ);
    const float* ct = (const float*)(ws + WS_COS); const float* st = (const float*)(ws + WS_SIN);
    const int r32 = lane & 31, hi = lane >> 5;
    LAS float* xb = (LAS float*)(lds + RING_OFF) + (wave >> 1) * 1024;
    for (int task2 = gw; task2 < 2 * 64 * 16; task2 += NGW) {
        const int task = task2 >> 1, kh = task2 & 1;
        const int combo = task >> 4, nb = (task >> 2) & 3, eb = task & 3, kv = combo & 1, h = (combo >> 1) & 3, b = combo >> 3;
        const int p = eb * 32 + r32;
        const int e = kv ? p : (64 * ((p >> 2) & 1) + 4 * (p >> 3) + (p & 3));
        int n = nb * 32 + r32; if (n > 126) n = 126;
        const bf16* arow = HQ + ((size_t)((kv ? C_VC : C_KC) / HD + h) * M + b * T + 16 * n + 16 * kh) * HD + hi * 8;
        const bf16* brow = (const bf16*)(ws + (kv ? WS_WCVT : WS_WCKT)) + (size_t)e * 4096 + kh * 2048 + hi * 8;
        f32x16 acc = {};
#pragma unroll 16
        for (int s = 0; s < 128; ++s) { const int l = s >> 3, d0 = (s & 7) * 16;
            const bf16x8 a = *(const bf16x8*)(arow + l * HD + d0), bb = *(const bf16x8*)(brow + s * 16);
            acc = __builtin_amdgcn_mfma_f32_32x32x16_bf16(a, bb, acc, 0, 0, 0); }
        __syncthreads();
        if (kh) {
#pragma unroll
            for (int r = 0; r < 16; ++r) xb[r * 64 + lane] = acc[r]; }
        __syncthreads();
        if (!kh) {
            const float cst = ((const float*)(ws + (kv ? WS_CV : WS_CK)))[e];
            bf16* outp = (bf16*)(ws + (kv ? WS_VC : WS_KC)) + (size_t)((b * 4 + h) * 128) * 128 + p;
#pragma unroll
            for (int r = 0; r < 16; ++r) { const int nr = nb * 32 + (r & 3) + 8 * (r >> 2) + 4 * hi; float v = (acc[r] + xb[r * 64 + lane]) + cst;
                if (!kv) { const float pv = __shfl_xor(v, 4); int pos = 16 * nr + 31; if (pos > T - 1) pos = T - 1; const int i = 4 * (p >> 3) + (p & 3); const float c = ct[pos * 64 + i], s = st[pos * 64 + i];
                    v = ((p >> 2) & 1) ? (pv * s + v * c) : (v * c - pv * s); }
                outp[(size_t)nr * 128] = (bf16)(cvtpk(v, v) & 0xffffu); } }
    }
}

namespace at {
constexpr float SCALE = 0.088388347648318440f, CS = SCALE * 1.4426950408889634f;
constexpr float NEGM = -2.0e30f, MINIT = -1.0e30f;
constexpr int ATT_K = 0, ATT_V = 32768, ATT_K2 = 65536, ATT_V2 = 81920, ATT_IMP = 65536, ATT_WS = 98304, ATT_FLAG = ATT_WS + 2048, ATT_SELM = ATT_FLAG + 256;
#define KSWZ(row, colB) ((row) * 256 + ((colB) ^ (((row) & 7) << 4)))
#define SBAR() __builtin_amdgcn_sched_barrier(0)
__device__ __forceinline__ int crow(int r, int hi) { return (r & 3) + 8 * (r >> 2) + 4 * hi; }
__device__ __forceinline__ int v_st(int k, int c) { const int kk = (k & ~0xC) | ((k & 4) << 1) | ((k & 8) >> 1); return ((kk >> 3) * 4 + (c >> 5)) * 512 + ((kk & 7) * 32 + (c & 31)) * 2; }
__device__ __forceinline__ int v_rd_base(int lane) { return ((lane & 3) << 3) | (((lane >> 2) & 3) << 6) | (((lane >> 4) & 1) << 5) | (((lane >> 5) & 1) << 8); }
constexpr int v_rd_off(int d0, int ks, int half) { return d0 * 512 + ks * 4096 + half * 2048; }
template <int OFF> __device__ __forceinline__ s16x4 tr_read(int vb) { s16x4 r; asm volatile("ds_read_b64_tr_b16 %0, %1 offset:%2" : "=&v"(r) : "v"(vb), "i"(OFF) : "memory"); return r; }
struct VF { s16x4 l0, h0, l1, h1, l2, h2, l3, h3; };
template <int KS> __device__ __forceinline__ VF pv_read(int vb) { VF f;
    f.l0 = tr_read<v_rd_off(0, KS, 0)>(vb); f.h0 = tr_read<v_rd_off(0, KS, 1)>(vb); f.l1 = tr_read<v_rd_off(1, KS, 0)>(vb); f.h1 = tr_read<v_rd_off(1, KS, 1)>(vb);
    f.l2 = tr_read<v_rd_off(2, KS, 0)>(vb); f.h2 = tr_read<v_rd_off(2, KS, 1)>(vb); f.l3 = tr_read<v_rd_off(3, KS, 0)>(vb); f.h3 = tr_read<v_rd_off(3, KS, 1)>(vb); return f; }
__device__ __forceinline__ void pv_mma(f32x16 (&o)[4], bf16x8 pa, const VF& f) {
#define PK(L, H) (bf16x8){L[0], L[1], L[2], L[3], H[0], H[1], H[2], H[3]}
    o[0] = __builtin_amdgcn_mfma_f32_32x32x16_bf16(pa, PK(f.l0, f.h0), o[0], 0, 0, 0);
    o[1] = __builtin_amdgcn_mfma_f32_32x32x16_bf16(pa, PK(f.l1, f.h1), o[1], 0, 0, 0);
    o[2] = __builtin_amdgcn_mfma_f32_32x32x16_bf16(pa, PK(f.l2, f.h2), o[2], 0, 0, 0);
    o[3] = __builtin_amdgcn_mfma_f32_32x32x16_bf16(pa, PK(f.l3, f.h3), o[3], 0, 0, 0);
#undef PK
}
__device__ __forceinline__ void pv_d0(f32x16 (&o)[4], int vb, bf16x8 pa0, bf16x8 pa1, bf16x8 pa2, bf16x8 pa3) {
    const VF f0 = pv_read<0>(vb); const VF f1 = pv_read<1>(vb);
    asm volatile("s_waitcnt lgkmcnt(8)" ::: "memory"); SBAR(); pv_mma(o, pa0, f0);
    const VF f2 = pv_read<2>(vb);
    asm volatile("s_waitcnt lgkmcnt(8)" ::: "memory"); SBAR(); pv_mma(o, pa1, f1);
    const VF f3 = pv_read<3>(vb);
    asm volatile("s_waitcnt lgkmcnt(8)" ::: "memory"); SBAR(); pv_mma(o, pa2, f2);
    asm volatile("s_waitcnt lgkmcnt(0)" ::: "memory"); SBAR(); pv_mma(o, pa3, f3);
}
__device__ __forceinline__ void k_rd(bf16x8& a, bf16x8& b, unsigned addr) {
    asm volatile("ds_read_b128 %0, %2\n\tds_read_b128 %1, %2 offset:8192" : "=&v"(a), "=&v"(b) : "v"(addr) : "memory"); }
#define K_WAIT(n, a, b) asm volatile("s_waitcnt lgkmcnt(" #n ")" : "+v"(a), "+v"(b) :: "memory")
__device__ __forceinline__ void qkt(f32x16& p0, f32x16& p1, const LAS unsigned char* Ks, const bf16x8 (&qr)[8], int r32, int hi) {
    const unsigned base = (unsigned)(uintptr_t)Ks + (unsigned)(r32 * 256), sw = (unsigned)((r32 & 7) << 4), h16 = (unsigned)(hi * 16);
#define K_ADDR(d0) (base + (((unsigned)((d0) * 32) + h16) ^ sw))
    bf16x8 a0, b0, a1, b1, a2, b2;
    k_rd(a0, b0, K_ADDR(0)); k_rd(a1, b1, K_ADDR(1)); k_rd(a2, b2, K_ADDR(2));
    p0 = f32x16{}; p1 = f32x16{};
    K_WAIT(4, a0, b0); p0 = __builtin_amdgcn_mfma_f32_32x32x16_bf16(a0, qr[0], p0, 0, 0, 0); p1 = __builtin_amdgcn_mfma_f32_32x32x16_bf16(b0, qr[0], p1, 0, 0, 0); k_rd(a0, b0, K_ADDR(3));
    K_WAIT(4, a1, b1); p0 = __builtin_amdgcn_mfma_f32_32x32x16_bf16(a1, qr[1], p0, 0, 0, 0); p1 = __builtin_amdgcn_mfma_f32_32x32x16_bf16(b1, qr[1], p1, 0, 0, 0); k_rd(a1, b1, K_ADDR(4));
    K_WAIT(4, a2, b2); p0 = __builtin_amdgcn_mfma_f32_32x32x16_bf16(a2, qr[2], p0, 0, 0, 0); p1 = __builtin_amdgcn_mfma_f32_32x32x16_bf16(b2, qr[2], p1, 0, 0, 0); k_rd(a2, b2, K_ADDR(5));
    K_WAIT(4, a0, b0); p0 = __builtin_amdgcn_mfma_f32_32x32x16_bf16(a0, qr[3], p0, 0, 0, 0); p1 = __builtin_amdgcn_mfma_f32_32x32x16_bf16(b0, qr[3], p1, 0, 0, 0); k_rd(a0, b0, K_ADDR(6));
    K_WAIT(4, a1, b1); p0 = __builtin_amdgcn_mfma_f32_32x32x16_bf16(a1, qr[4], p0, 0, 0, 0); p1 = __builtin_amdgcn_mfma_f32_32x32x16_bf16(b1, qr[4], p1, 0, 0, 0); k_rd(a1, b1, K_ADDR(7));
    K_WAIT(4, a2, b2); p0 = __builtin_amdgcn_mfma_f32_32x32x16_bf16(a2, qr[5], p0, 0, 0, 0); p1 = __builtin_amdgcn_mfma_f32_32x32x16_bf16(b2, qr[5], p1, 0, 0, 0);
    K_WAIT(2, a0, b0); p0 = __builtin_amdgcn_mfma_f32_32x32x16_bf16(a0, qr[6], p0, 0, 0, 0); p1 = __builtin_amdgcn_mfma_f32_32x32x16_bf16(b0, qr[6], p1, 0, 0, 0);
    K_WAIT(0, a1, b1); p0 = __builtin_amdgcn_mfma_f32_32x32x16_bf16(a1, qr[7], p0, 0, 0, 0); p1 = __builtin_amdgcn_mfma_f32_32x32x16_bf16(b1, qr[7], p1, 0, 0, 0);
#undef K_ADDR
}
#undef K_WAIT
__device__ __forceinline__ float pair_max(float x) { auto rr = __builtin_amdgcn_permlane32_swap(__float_as_uint(x), __float_as_uint(x), false, false); return fmaxf(__uint_as_float(rr[0]), __uint_as_float(rr[1])); }
__device__ __forceinline__ float pair_sum(float x) { auto rr = __builtin_amdgcn_permlane32_swap(__float_as_uint(x), __float_as_uint(x), false, false); return __uint_as_float(rr[0]) + __uint_as_float(rr[1]); }
__device__ __forceinline__ float pair_other(float x, int hi) { auto rr = __builtin_amdgcn_permlane32_swap(__float_as_uint(x), __float_as_uint(x), false, false); return __uint_as_float(hi ? rr[0] : rr[1]); }
__device__ __forceinline__ void p_to_frags(const f32x16& p0, const f32x16& p1, bf16x8& pa0, bf16x8& pa1, bf16x8& pa2, bf16x8& pa3) {
#define PK4(P, BASE, OUT) do { unsigned a0 = cvtpk(P[BASE + 0], P[BASE + 1]), a1 = cvtpk(P[BASE + 2], P[BASE + 3]);   \
    unsigned b0 = cvtpk(P[BASE + 4], P[BASE + 5]), b1 = cvtpk(P[BASE + 6], P[BASE + 7]);                              \
    auto r0 = __builtin_amdgcn_permlane32_swap(a0, b0, false, false); auto r1 = __builtin_amdgcn_permlane32_swap(a1, b1, false, false); \
    v4u w = {r0[0], r1[0], r0[1], r1[1]}; OUT = *reinterpret_cast<bf16x8*>(&w); } while (0)
    PK4(p0, 0, pa0); PK4(p0, 8, pa1); PK4(p1, 0, pa2); PK4(p1, 8, pa3);
#undef PK4
}
constexpr float THR_RAW = 8.f / SCALE;
__device__ __forceinline__ float softmax_tile(f32x16& p0, f32x16& p1, float& m_reg, float& l_reg, f32x16 (&o)[4], LAS float* al_l, int r32, int hi, bool lane_on = true) {
    float pmax = fmaxf(fmaxf(p0[0], p0[1]), p0[2]);
#pragma unroll
    for (int r = 3; r < 15; r += 2) pmax = fmaxf(fmaxf(pmax, p0[r]), p0[r + 1]);
    pmax = fmaxf(fmaxf(pmax, p0[15]), p1[0]);
#pragma unroll
    for (int r = 1; r < 15; r += 2) pmax = fmaxf(fmaxf(pmax, p1[r]), p1[r + 1]);
    pmax = fmaxf(pmax, p1[15]);
    pmax = pair_max(pmax); pmax = lane_on ? pmax : NEGM;
    float mn = m_reg, alpha = 1.f;
    if (!__all(pmax - m_reg <= THR_RAW)) { mn = fmaxf(m_reg, pmax); alpha = __builtin_amdgcn_exp2f((m_reg - mn) * CS); m_reg = mn;
        if (hi == 0) al_l[r32] = alpha; LDS_WAIT();
#pragma unroll
        for (int d = 0; d < 4; ++d)
#pragma unroll
            for (int r = 0; r < 16; ++r) o[d][r] *= al_l[crow(r, hi)];
        LDS_WAIT(); }
    const float mnC = lane_on ? -mn * CS : -__builtin_inff();
#pragma unroll
    for (int r = 0; r < 16; ++r) { p0[r] = __builtin_amdgcn_exp2f(fmaf(p0[r], CS, mnC)); p1[r] = __builtin_amdgcn_exp2f(fmaf(p1[r], CS, mnC)); }
    float ps = 0.f;
#pragma unroll
    for (int r = 0; r < 16; ++r) ps += p0[r] + p1[r];
    ps = pair_sum(ps);
    l_reg = l_reg * alpha + ps;
    return alpha;
}
struct Stage { bf16x8 k0, k1, v0, v1; };
__device__ __forceinline__ void kv_load(Stage& s, const bf16* Kg, const bf16* Vg, int ld, int row0, int sr, int sc) {
    const unsigned o0 = (unsigned)((row0 + sr) * ld + sc), o1 = o0 + (unsigned)(32 * ld);
    s.k0 = *(const bf16x8*)(Kg + o0); s.k1 = *(const bf16x8*)(Kg + o1); s.v0 = *(const bf16x8*)(Vg + o0); s.v1 = *(const bf16x8*)(Vg + o1);
}
__device__ __forceinline__ void kv_write(const Stage& s, LAS unsigned char* Kb, LAS unsigned char* Vb, int sr, int sc) {
    *(LAS bf16x8*)(Vb + v_st(sr, sc)) = s.v0; *(LAS bf16x8*)(Vb + v_st(32 + sr, sc)) = s.v1;
    *(LAS bf16x8*)(Kb + KSWZ(sr, sc * 2)) = s.k0; *(LAS bf16x8*)(Kb + KSWZ(32 + sr, sc * 2)) = s.k1;
}
template <bool EARLY, class Body>
__device__ __forceinline__ void kv_tile_loop(const bf16* Kg, const bf16* Vg, int ld, int t_first, int n_tiles, int step, LAS unsigned char* lds, int tid, int lane, Body&& body) {
    int tid_o = tid; asm volatile("" : "+v"(tid_o));
    const int sr = tid_o >> 4, sc = (tid_o & 15) * 8;
    Stage st; kv_load(st, Kg, Vg, ld, 64 * t_first, sr, sc);
    __syncthreads();
    kv_write(st, lds + ATT_K, lds + ATT_V, sr, sc);
    __syncthreads();
    for (int i = 0; i < n_tiles; ++i) { const int tile = t_first + i * step, b = i & 1;
        if (i + 1 < n_tiles) kv_load(st, Kg, Vg, ld, 64 * (tile + step), sr, sc);
        body(tile, i, (const LAS unsigned char*)(lds + ATT_K + b * 16384), (int)(unsigned)(uintptr_t)(lds + ATT_V + b * 16384) + v_rd_base(lane));
        if (i + 1 < n_tiles) kv_write(st, lds + ATT_K + (b ^ 1) * 16384, lds + ATT_V + (b ^ 1) * 16384, sr, sc);
        __syncthreads();
        if (EARLY) { const LAS unsigned* fl = (const LAS unsigned*)(lds + ATT_FLAG) + 8 * b; unsigned a = 1u;
#pragma unroll
            for (int w = 0; w < 8; ++w) a &= fl[w];
            if (a) break; }
    }
}
template <class QK, class SM, class PV>
__device__ __forceinline__ void kv_tile_loop_skew(const bf16* Kg, const bf16* Vg, int ld, int t_first, int n_tiles, LAS unsigned char* lds, int tid, int lane, bool late, QK&& qk, SM&& sm, PV&& pv) {
    asm volatile("" : "+v"(lane));
    const int wv = __builtin_amdgcn_readfirstlane(tid >> 6), vlane = v_rd_base(lane);
    unsigned offK, offV;
    { const int row = 4 * wv + (lane >> 4), cb = ((lane & 15) * 16) ^ ((row & 7) << 4); offK = (unsigned)(row * ld + cb / 2);
      const int sidx = 2 * wv + (lane >> 5), kk = (sidx >> 2) * 8 + ((lane & 31) >> 2), k = (kk & ~0xC) | ((kk & 4) << 1) | ((kk & 8) >> 1), c = (sidx & 3) * 32 + (lane & 3) * 8; offV = (unsigned)(k * ld + c); }
#define KBUF(i) ((i) < 2 ? ATT_K + (i) * 16384 : ATT_K2)
#define VBUF(i) ((i) < 2 ? ATT_V + (i) * 16384 : ATT_V2)
#define DMA_TILE(tile, b) do { const bf16* kt_ = Kg + (size_t)(64 * (tile)) * ld; const bf16* vt_ = Vg + (size_t)(64 * (tile)) * ld;                                                   \
        __builtin_amdgcn_global_load_lds((const unsigned*)(kt_ + offK), (LAS unsigned*)(lds + KBUF(b) + wv * 1024), 16, 0, 0);                                                       \
        __builtin_amdgcn_global_load_lds((const unsigned*)(kt_ + offK + (unsigned)(32 * ld)), (LAS unsigned*)(lds + KBUF(b) + (wv + 8) * 1024), 16, 0, 0);                         \
        __builtin_amdgcn_global_load_lds((const unsigned*)(vt_ + offV), (LAS unsigned*)(lds + VBUF(b) + wv * 1024), 16, 0, 0);                                                       \
        __builtin_amdgcn_global_load_lds((const unsigned*)(vt_ + offV + (unsigned)(32 * ld)), (LAS unsigned*)(lds + VBUF(b) + (wv + 8) * 1024), 16, 0, 0); } while (0)
#define WG_BAR() do { asm volatile("s_waitcnt lgkmcnt(0)" ::: "memory"); __builtin_amdgcn_s_barrier(); asm volatile("" ::: "memory"); } while (0)
    __syncthreads();
    DMA_TILE(t_first, 0);
    if (n_tiles > 1) { DMA_TILE(t_first + 1, 1); asm volatile("s_waitcnt vmcnt(4)" ::: "memory"); } else asm volatile("s_waitcnt vmcnt(0)" ::: "memory");
    WG_BAR();
    int b = 0;
    for (int i = 0; i < n_tiles; ++i) { const int tile = t_first + i, b2 = b == 0 ? 2 : b - 1, b1 = b == 2 ? 0 : b + 1;
        if (i + 2 < n_tiles) DMA_TILE(tile + 2, b2);
        qk((const LAS unsigned char*)(lds + KBUF(b))); sm(tile); pv((int)(unsigned)(uintptr_t)(lds + VBUF(b)) + vlane);
        if (i + 1 < n_tiles) { if (i + 2 < n_tiles) asm volatile("s_waitcnt vmcnt(4)" ::: "memory"); else asm volatile("s_waitcnt vmcnt(0)" ::: "memory"); }
        WG_BAR();
        b = b1; }
#undef KBUF
#undef VBUF
#undef DMA_TILE
#undef WG_BAR
    (void)late;
}
constexpr ptrdiff_t OACC1_OFF = 64 * 512;
template <int MODE>
__device__ __forceinline__ void scale_store(const f32x16 (&o)[4], float f, LAS float* li_l, int r32, int hi, float* oacc_row0, bf16* oc_row0, int ldacc, int ldoc) {
    if (hi == 0) li_l[r32] = f; LDS_WAIT();
    float rf[16];
#pragma unroll
    for (int r = 0; r < 16; ++r) rf[r] = li_l[crow(r, hi)];
    LDS_WAIT();
    int orow = 4 * hi;
#pragma unroll
    for (int rb = 0; rb < 4; ++rb) { asm volatile("" : "+v"(orow));
        float a0[4][4], a1[4][4];
        if (MODE == 2) {
#pragma unroll
            for (int j = 0; j < 4; ++j)
#pragma unroll
                for (int d0 = 0; d0 < 4; ++d0) { const unsigned ia = (unsigned)((orow + j) * ldacc + d0 * 32 + r32); a0[j][d0] = oacc_row0[ia]; a1[j][d0] = (oacc_row0 + OACC1_OFF)[ia]; } }
#pragma unroll
        for (int j = 0; j < 4; ++j)
#pragma unroll
            for (int d0 = 0; d0 < 4; ++d0) { float v = o[d0][4 * rb + j] * rf[4 * rb + j]; const unsigned ia = (unsigned)((orow + j) * ldacc + d0 * 32 + r32), ic = (unsigned)((orow + j) * ldoc + d0 * 32 + r32);
                if (MODE == 0) oacc_row0[ia] = v;
                if (MODE == 1) (oacc_row0 + OACC1_OFF)[ia] = v;
                if (MODE == 2) v += a0[j][d0] + a1[j][d0];
                if (MODE >= 2) oc_row0[ic] = (bf16)(cvtpk(v, v) & 0xffffu); }
        orow += 8;
        asm volatile("" ::: "memory"); }
}
__device__ __forceinline__ float sigmoidf_(float x) { return 1.f / (1.f + __expf(-x)); }


__device__ __forceinline__ void nsa_unit(const Ptrs& P, LAS unsigned char* lds, int combo, int qt, int tid, int wave, int lane) {
    unsigned char* ws = P.ws; const bf16* HQ = (const bf16*)(ws + WS_HQ);
    const int r32 = lane & 31, hi = lane >> 5, g = wave & 3, qh = wave >> 2;
    const int b = combo >> 2, kvh = combo & 3, head = kvh * 4 + g;
    const int tq = 64 * qt + 32 * qh + r32;
    const size_t mrow0 = (size_t)b * T + 64 * qt + 32 * qh;
    LAS float* wsl = (LAS float*)(lds + ATT_WS) + wave * 64; LAS float* li_l = wsl; LAS float* al_l = wsl + 32;
    bf16x8 qr[8];
    { const bf16* Qw = HQ + ((size_t)(C_QA / HD + head) * M + mrow0) * HD; const unsigned qo = (unsigned)(r32 * HD + hi * 8);
#pragma unroll
      for (int d0 = 0; d0 < 8; ++d0) qr[d0] = *(const bf16x8*)(Qw + (qo + d0 * 16)); }
    float* oacc_row0 = (float*)(ws + WS_OACC) + (size_t)blockIdx.x * (2 * 64 * 512) + (32 * qh) * 512 + g * HD; bf16* oc_row0 = (bf16*)(ws + WS_OC) + mrow0 * D + head * HD;
    const bf16* grow = HQ + ((size_t)(C_GATE / HD) * M + mrow0) * HD + head; const unsigned go = (unsigned)(r32 * HD);
    f32x16 o[4]; float m_reg, l_reg;
    {
        float gs[16], e3[16];
#pragma unroll
        for (int a = 0; a < 16; ++a) { gs[a] = 0.f; e3[a] = 0.f; }
        int tid_o = tid; asm volatile("" : "+v"(tid_o));
        const int ntc = (4 * qt + 2) / 64 + 1, sr = tid_o >> 4, sc = (tid_o & 15) * 8;
        const bf16* Kg = (const bf16*)(ws + WS_KC) + (size_t)combo * 128 * 128; const bf16* Vg = (const bf16*)(ws + WS_VC) + (size_t)combo * 128 * 128;
        Stage st; kv_load(st, Kg, Vg, 128, 0, sr, sc);
        __syncthreads();
        kv_write(st, lds + ATT_K, lds + ATT_V, sr, sc);
        if (ntc == 2) { kv_load(st, Kg, Vg, 128, 64, sr, sc); kv_write(st, lds + ATT_K + 16384, lds + ATT_V + 16384, sr, sc); }
        __syncthreads();
#pragma unroll
        for (int d = 0; d < 4; ++d) o[d] = f32x16{};
        m_reg = MINIT; l_reg = 0.f;
#define CMP_TILE(TI) do { f32x16 p0, p1; qkt(p0, p1, (const LAS unsigned char*)(lds + ATT_K + (TI) * 16384), qr, r32, hi);                                   \
        { const int nlim = ((tq - 31) >> 4) - 4 * hi - 64 * (TI);              \
        _Pragma("unroll") for (int r = 0; r < 16; ++r) { const int kr = (r & 3) + 8 * (r >> 2);                                                              \
            p0[r] = (kr <= nlim) ? p0[r] : NEGM; p1[r] = (kr + 32 <= nlim) ? p1[r] : NEGM; } }                                                                \
        const float alpha = softmax_tile(p0, p1, m_reg, l_reg, o, al_l, r32, hi);                                                                             \
        if ((TI) == 1) { _Pragma("unroll") for (int a = 0; a < 8; ++a) { gs[a] *= alpha; e3[a] *= alpha; } }                                                  \
        _Pragma("unroll") for (int a = 0; a < 4; ++a) { gs[8 * (TI) + a] = (p0[4 * a] + p0[4 * a + 1]) + (p0[4 * a + 2] + 0.5f * p0[4 * a + 3]); e3[8 * (TI) + a] = 0.5f * p0[4 * a + 3];   \
            gs[8 * (TI) + 4 + a] = (p1[4 * a] + p1[4 * a + 1]) + (p1[4 * a + 2] + 0.5f * p1[4 * a + 3]); e3[8 * (TI) + 4 + a] = 0.5f * p1[4 * a + 3]; }     \
        bf16x8 pa0, pa1, pa2, pa3; p_to_frags(p0, p1, pa0, pa1, pa2, pa3);                                                                                   \
        pv_d0(o, (int)(unsigned)(uintptr_t)(lds + ATT_V + (TI) * 16384) + v_rd_base(lane), pa0, pa1, pa2, pa3); } while (0)
        CMP_TILE(0);
        if (ntc == 2) CMP_TILE(1);
#undef CMP_TILE
        const float inv = l_reg > 0.f ? 1.f / l_reg : 0.f;
        LAS float* imp = (LAS float*)(lds + ATT_IMP) + (g * 64 + qh * 32 + r32) * 32;
        float oprev = 0.f;
#pragma unroll
        for (int a = 0; a < 16; ++a) { const float oth = pair_other(e3[a], hi);
            imp[2 * a + hi] = (gs[a] + (hi ? oth : oprev)) * inv; oprev = oth; }
        const float gate = sigmoidf_(bf2f(grow[go]));
        scale_store<0>(o, gate * inv, li_l, r32, hi, oacc_row0, oc_row0, 512, D);
    }
    __syncthreads();
    {
        const int q = tid >> 3, sub = tid & 7; const LAS float* ip = (const LAS float*)(lds + ATT_IMP) + q * 32;
        float vv[32];
#pragma unroll
        for (int j = 0; j < 32; ++j) { const float v = ((ip[j] + ip[2048 + j]) + ip[4096 + j]) + ip[6144 + j];
            vv[j] = ((j == 0) | (j == qt) | (j == qt - 1)) ? 1e9f : (j <= qt ? v : -1e30f); }
        unsigned bits = 0u;
#pragma unroll
        for (int jj = 0; jj < 4; ++jj) { const int j = 4 * sub + jj; const float v = ((ip[j] + ip[2048 + j]) + ip[4096 + j]) + ip[6144 + j];
            const float mv = ((j == 0) | (j == qt) | (j == qt - 1)) ? 1e9f : (j <= qt ? v : -1e30f); int cnt = 0;
#pragma unroll
            for (int i = 0; i < 32; ++i) cnt += ((vv[i] > mv) | ((vv[i] == mv) & (i < j))) ? 1 : 0;
            if (cnt < 16 && j <= qt) bits |= 1u << j; }
        bits |= __shfl_xor(bits, 1); bits |= __shfl_xor(bits, 2); bits |= __shfl_xor(bits, 4);
        if (sub == 0) ((LAS unsigned*)(lds + ATT_SELM))[q] = bits;
    }
    __syncthreads();
    const unsigned selmask = ((const LAS unsigned*)(lds + ATT_SELM))[qh * 32 + r32];
    {
#pragma unroll
        for (int d = 0; d < 4; ++d) o[d] = f32x16{};
        m_reg = MINIT; l_reg = 0.f;
        const bf16* Kg = HQ + ((size_t)(C_KS / HD + kvh) * M + (size_t)b * T) * HD; const bf16* Vg = HQ + ((size_t)(C_VS / HD + kvh) * M + (size_t)b * T) * HD;
        f32x16 p0, p1; bf16x8 pa0, pa1, pa2, pa3;
        kv_tile_loop_skew(Kg, Vg, HD, 0, qt + 1, lds, tid, lane, qh != 0,
            [&](const LAS unsigned char* Ks) { qkt(p0, p1, Ks, qr, r32, hi); },
            [&](int tile) { const bool on = (selmask >> tile) & 1u;
                if (tile == qt) { const int lim = tq - 64 * tile - 4 * hi;
#pragma unroll
                    for (int r = 0; r < 16; ++r) { const int kr = (r & 3) + 8 * (r >> 2); p0[r] = (kr <= lim) ? p0[r] : NEGM; p1[r] = (kr + 32 <= lim) ? p1[r] : NEGM; } }
                softmax_tile(p0, p1, m_reg, l_reg, o, al_l, r32, hi, on); p_to_frags(p0, p1, pa0, pa1, pa2, pa3); },
            [&](int vb) { pv_d0(o, vb, pa0, pa1, pa2, pa3);
#if defined(MK_XPV)
                { f32x16 od[4]; od[0] = f32x16{}; od[1] = f32x16{}; od[2] = f32x16{}; od[3] = f32x16{}; asm volatile("" ::: "memory"); pv_d0(od, vb, pa0, pa1, pa2, pa3); asm volatile("" :: "v"(od[0]), "v"(od[1]), "v"(od[2]), "v"(od[3])); }
#endif
            });
        const float inv = l_reg > 0.f ? 1.f / l_reg : 0.f;
        const float gate = sigmoidf_(bf2f(grow[go + 16]));
        scale_store<1>(o, gate * inv, li_l, r32, hi, oacc_row0, oc_row0, 512, D);
    }
    {
#pragma unroll
        for (int d = 0; d < 4; ++d) o[d] = f32x16{};
        m_reg = MINIT; l_reg = 0.f;
        const bf16* Kg = HQ + ((size_t)(C_KW / HD + kvh) * M + (size_t)b * T) * HD; const bf16* Vg = HQ + ((size_t)(C_VW / HD + kvh) * M + (size_t)b * T) * HD;
        const int t_lo = qt - 8 > 0 ? qt - 8 : 0;
        f32x16 p0, p1; bf16x8 pa0, pa1, pa2, pa3;
        kv_tile_loop_skew(Kg, Vg, HD, t_lo, qt - t_lo + 1, lds, tid, lane, qh != 0,
            [&](const LAS unsigned char* Ks) { qkt(p0, p1, Ks, qr, r32, hi); },
            [&](int tile) {
                if (tile == qt || tile == qt - 8) { const int lim = tq - 64 * tile - 4 * hi;
#pragma unroll
                    for (int r = 0; r < 16; ++r) { const int kr = (r & 3) + 8 * (r >> 2); p0[r] = (kr <= lim && kr > lim - 512) ? p0[r] : NEGM; p1[r] = (kr + 32 <= lim && kr + 32 > lim - 512) ? p1[r] : NEGM; } }
                softmax_tile(p0, p1, m_reg, l_reg, o, al_l, r32, hi); p_to_frags(p0, p1, pa0, pa1, pa2, pa3); },
            [&](int vb) { pv_d0(o, vb, pa0, pa1, pa2, pa3);
#if defined(MK_XPV)
                { f32x16 od[4]; od[0] = f32x16{}; od[1] = f32x16{}; od[2] = f32x16{}; od[3] = f32x16{}; asm volatile("" ::: "memory"); pv_d0(od, vb, pa0, pa1, pa2, pa3); asm volatile("" :: "v"(od[0]), "v"(od[1]), "v"(od[2]), "v"(od[3])); }
#endif
            });
        const float inv = l_reg > 0.f ? 1.f / l_reg : 0.f;
        const float gate = sigmoidf_(bf2f(grow[go + 32]));
        scale_store<2>(o, gate * inv, li_l, r32, hi, oacc_row0, oc_row0, 512, D);
    }
}

__device__ __forceinline__ void sb_unit(const Ptrs& P, LAS unsigned char* lds, int combo, int qt, int tid, int wave, int lane) {
    unsigned char* ws = P.ws; const bf16* HQ = (const bf16*)(ws + WS_HQ);
    const int r32 = lane & 31, hi = lane >> 5;
    const int b = combo >> 4, h = combo & 15;
    const int tq0 = 256 * qt + 32 * wave, tq = tq0 + r32;
    const size_t mrow0 = (size_t)b * T + tq0;
    LAS float* li_l = (LAS float*)(lds + ATT_WS) + wave * 64;
    bf16x8 qr[8];
    { const bf16* Qw = HQ + ((size_t)(C_QB / HD + h) * M + mrow0) * HD; const unsigned qo = (unsigned)(r32 * HD + hi * 8);
#pragma unroll
      for (int d0 = 0; d0 < 8; ++d0) qr[d0] = *(const bf16x8*)(Qw + (qo + d0 * 16)); }
    f32x16 o[4];
#pragma unroll
    for (int d = 0; d < 4; ++d) o[d] = f32x16{};
    float R = 0.f; bool done = false;
    const bf16* Kg = HQ + ((size_t)(C_KB / HD + h) * M + (size_t)b * T) * HD; const bf16* Vg = HQ + ((size_t)(C_VB / HD + h) * M + (size_t)b * T) * HD;
    const int tile_hi = 4 * qt + 3;
    kv_tile_loop<true>(Kg, Vg, HD, tile_hi, tile_hi + 1, -1, lds, tid, lane, [&](int tile, int it, const LAS unsigned char* Ks, int vb) {
        if (64 * tile <= tq0 + 30 && !done) {
            f32x16 p0, p1, s0, s1; qkt(p0, p1, Ks, qr, r32, hi);
            const int lim = tq - 64 * tile - 4 * hi;
#pragma unroll
            for (int r = 0; r < 16; ++r) { const int kr = (r & 3) + 8 * (r >> 2);
                { const float z = (kr < lim) ? p0[r] * CS : MINIT, sp = fmaxf(z, 0.f) + __builtin_amdgcn_logf(1.f + __builtin_amdgcn_exp2f(-fabsf(z))); s0[r] = sp; p0[r] = z - sp; }
                { const float z = (kr + 32 < lim) ? p1[r] * CS : MINIT, sp = fmaxf(z, 0.f) + __builtin_amdgcn_logf(1.f + __builtin_amdgcn_exp2f(-fabsf(z))); s1[r] = sp; p1[r] = z - sp; } }
            float gsum[8], pg[8];
#pragma unroll
            for (int a = 0; a < 4; ++a) { gsum[a] = (s0[4 * a] + s0[4 * a + 1]) + (s0[4 * a + 2] + s0[4 * a + 3]); gsum[4 + a] = (s1[4 * a] + s1[4 * a + 1]) + (s1[4 * a + 2] + s1[4 * a + 3]); }
#pragma unroll
            for (int a = 0; a < 8; ++a) pg[a] = pair_other(gsum[a], hi);
            float suf = 0.f;
#pragma unroll
            for (int a = 3; a >= 0; --a) { const float base = R + suf + (hi ? 0.f : pg[4 + a]);
                const float l3 = base, l2 = l3 + s1[4 * a + 3], l1 = l2 + s1[4 * a + 2], l0 = l1 + s1[4 * a + 1];
                p1[4 * a + 3] = __builtin_amdgcn_exp2f(p1[4 * a + 3] - l3); p1[4 * a + 2] = __builtin_amdgcn_exp2f(p1[4 * a + 2] - l2); p1[4 * a + 1] = __builtin_amdgcn_exp2f(p1[4 * a + 1] - l1); p1[4 * a] = __builtin_amdgcn_exp2f(p1[4 * a] - l0);
                suf += gsum[4 + a] + pg[4 + a]; }
#pragma unroll
            for (int a = 3; a >= 0; --a) { const float base = R + suf + (hi ? 0.f : pg[a]);
                const float l3 = base, l2 = l3 + s0[4 * a + 3], l1 = l2 + s0[4 * a + 2], l0 = l1 + s0[4 * a + 1];
                p0[4 * a + 3] = __builtin_amdgcn_exp2f(p0[4 * a + 3] - l3); p0[4 * a + 2] = __builtin_amdgcn_exp2f(p0[4 * a + 2] - l2); p0[4 * a + 1] = __builtin_amdgcn_exp2f(p0[4 * a + 1] - l1); p0[4 * a] = __builtin_amdgcn_exp2f(p0[4 * a] - l0);
                suf += gsum[a] + pg[a]; }
            R += suf;
            bf16x8 pa0, pa1, pa2, pa3; p_to_frags(p0, p1, pa0, pa1, pa2, pa3);
            pv_d0(o, vb, pa0, pa1, pa2, pa3);
            done = __all(R >= 160.f);
        }
        if (lane == 0) ((LAS unsigned*)(lds + ATT_FLAG))[8 * (it & 1) + wave] = done ? 1u : 0u; });
    scale_store<3>(o, 1.f, li_l, r32, hi, nullptr, (bf16*)(ws + WS_OC) + mrow0 * D + 2048 + h * HD, 0, D);
}

__device__ __forceinline__ void sb_naive(const Ptrs& P, int gw, int NGW, int lane) {
    unsigned char* ws = P.ws; const bf16* HQ = (const bf16*)(ws + WS_HQ); bf16* OC = (bf16*)(ws + WS_OC);
    for (int item = gw; item < M * 16; item += NGW) { const int m = item >> 4, h = item & 15, t = m & (T - 1);
        const bf16* q = HQ + ((size_t)(C_QB / HD + h) * M + m) * HD + 2 * lane; const float q0 = bf2f(q[0]), q1 = bf2f(q[1]);
        float o0 = 0.f, o1 = 0.f, later = 0.f;
        for (int s = t - 1; s >= 0 && later < 111.f; --s) {
            const bf16* kr = HQ + ((size_t)(C_KB / HD + h) * M + (m - t + s)) * HD + 2 * lane; const bf16* vr = HQ + ((size_t)(C_VB / HD + h) * M + (m - t + s)) * HD + 2 * lane;
            const float z = wave_sum(q0 * bf2f(kr[0]) + q1 * bf2f(kr[1])) * SCALE;
            const float sp = fmaxf(z, 0.f) + __logf(1.f + __expf(-fabsf(z))), a = __expf(z - sp - later);
            o0 += a * bf2f(vr[0]); o1 += a * bf2f(vr[1]); later += sp; }
        *(unsigned*)(OC + (size_t)m * D + 2048 + h * HD + 2 * lane) = cvtpk(o0, o1); }
}
#ifndef MK_SB_NAIVE
#define MK_SB_NAIVE 0
#endif
#ifndef MK_ATT_MASK
#define MK_ATT_MASK 3
#endif
__device__ __forceinline__ int pop_unit(unsigned* heads, int per_queue, int home, LAS unsigned* uq, int tid) {
    __syncthreads();
    if (tid == 0) { int r = -1;
        const unsigned idx = __hip_atomic_fetch_add(heads + 64 * home, 1u, __ATOMIC_RELAXED, __HIP_MEMORY_SCOPE_AGENT);
        if (idx < (unsigned)per_queue) r = home * per_queue + (int)idx;
        else for (int attempt = 0; attempt < 8; ++attempt) {
            unsigned h0, h1, h2, h3, h4, h5, h6, h7; const unsigned zero = 0u;
            asm volatile("global_load_dword %0, %8, %9 sc1\n\tglobal_load_dword %1, %8, %9 offset:256 sc1\n\tglobal_load_dword %2, %8, %9 offset:512 sc1\n\tglobal_load_dword %3, %8, %9 offset:768 sc1\n\t"
                         "global_load_dword %4, %8, %9 offset:1024 sc1\n\tglobal_load_dword %5, %8, %9 offset:1280 sc1\n\tglobal_load_dword %6, %8, %9 offset:1536 sc1\n\tglobal_load_dword %7, %8, %9 offset:1792 sc1\n\ts_waitcnt vmcnt(0)"
                         : "=&v"(h0), "=&v"(h1), "=&v"(h2), "=&v"(h3), "=&v"(h4), "=&v"(h5), "=&v"(h6), "=&v"(h7) : "v"(zero), "s"(heads) : "memory");
            int q = -1;
#pragma unroll
            for (int k = 7; k >= 0; --k) { const int qq = (home + k) & 7; const unsigned hv = qq == 0 ? h0 : qq == 1 ? h1 : qq == 2 ? h2 : qq == 3 ? h3 : qq == 4 ? h4 : qq == 5 ? h5 : qq == 6 ? h6 : h7; if (hv < (unsigned)per_queue) q = qq; }
            if (q < 0) break;
            const unsigned i2 = __hip_atomic_fetch_add(heads + 64 * q, 1u, __ATOMIC_RELAXED, __HIP_MEMORY_SCOPE_AGENT);
            if (i2 < (unsigned)per_queue) { r = q * per_queue + (int)i2; break; } }
        uq[0] = (unsigned)r; }
    __syncthreads();
    return __builtin_amdgcn_readfirstlane((int)uq[0]);
}
__device__ __forceinline__ void attention_phase(const Ptrs& P, LAS unsigned char* lds, unsigned* ctl, int tid, int wave, int lane, int amask = 3) {
    LAS unsigned* uq = (LAS unsigned*)(lds + ATT_FLAG + 128);
    const int home = (int)(xb_xcc_id() & 7u);
    if (MK_SB_NAIVE) { if (amask & 2) sb_naive(P, blockIdx.x * NWAVES + wave, gridDim.x * NWAVES, lane); }
    if (MK_ATT_MASK & amask & 1) for (;;) {
        const int r = pop_unit(ctl + CW_QNSA, 128, home, uq, tid); if (r < 0) break;
        const int q = r >> 7, idx = r & 127, combo = q + 8 * (idx >> 5), qt = 31 - (idx & 31);
        nsa_unit(P, lds, combo, qt, tid, wave, lane);
    }
    if (!MK_SB_NAIVE && (MK_ATT_MASK & amask & 2)) for (;;) {
        const int r = pop_unit(ctl + CW_QSB, 128, home, uq, tid); if (r < 0) break;
        const int q = r >> 7, idx = r & 127, combo = q + 8 * (idx >> 3), qt = 7 - (idx & 7);
        sb_unit(P, lds, combo, qt, tid, wave, lane);
    }
}
}

struct Args { const float* in[17]; float* out; unsigned char* ws; int ph_lo, ph_hi; };
__global__ void __launch_bounds__(NWAVES * 64, 2) fwd_kernel(Args args) {
    extern __shared__ __attribute__((aligned(16))) unsigned char lds_raw[];
    LAS unsigned char* lds = (LAS unsigned char*)lds_raw;
    volatile LAS unsigned* MISC = (volatile LAS unsigned*)(lds + MISC_OFF);
    const int tid = threadIdx.x, lane = tid & 63, wave = __builtin_amdgcn_readfirstlane(tid >> 6);
    const int G = gridDim.x, gw = blockIdx.x * NWAVES + wave, NGW = G * NWAVES;
    Ptrs P;
    P.x = args.in[0]; P.w_in = args.in[1]; P.w_out = args.in[2]; P.cmp_wk = args.in[3]; P.cmp_wv = args.in[4]; P.pe_k = args.in[5]; P.pe_v = args.in[6]; P.pool_w = args.in[7]; P.pool_scale = args.in[8];
    P.w_up = args.in[9]; P.conv_w = args.in[10]; P.conv_b = args.in[11]; P.w_down = args.in[12]; P.ln_mix_g = args.in[13]; P.ln_mix_b = args.in[14]; P.ln_ffn_g = args.in[15]; P.ln_ffn_b = args.in[16];
    P.out = args.out; P.ws = args.ws;
    unsigned char* ws = args.ws; unsigned* ctl = (unsigned*)(ws + WS_CTL);
    if (tid < 16) MISC[tid] = 0u;
    __syncthreads();
    XcdBarrier bar; bar.bar = ctl + CW_BAR; bar.x = 0; bar.st = nullptr;
    if (!MK_PER_PHASE) bar = xcd_barrier_post(ctl + CW_BAR, MISC);
    const int lo = args.ph_lo, hi = args.ph_hi;
#ifndef MK_PHASE_MASK
#define MK_PHASE_MASK 0xFFFFFFFFu
#endif
#define IN(k) (((MK_PHASE_MASK >> (k)) & 1u) && lo <= (k) && (k) < hi)
#define SEAM(k) do { if (IN(k) && IN((k) + 1)) xcd_barrier(bar); } while (0)
#ifndef MK_DUP_MASK
#define MK_DUP_MASK 0u
#endif
#define REPS(k) ((((MK_DUP_MASK) >> (k)) & 1u) ? 2 : 1)
    bf16* XB = (bf16*)(ws + WS_XB); _Float16* Y = (_Float16*)(ws + WS_Y); bf16* A2 = (bf16*)(ws + WS_A2); bf16* HQ = (bf16*)(ws + WS_HQ); bf16* OC = (bf16*)(ws + WS_OC); float* HALO = (float*)(ws + WS_H);

    float* STATS = (float*)(ws + WS_STATS); float* COLS = (float*)(ws + WS_COLS);
#define PHASE(k, ...) if (IN(k)) for (int rep = 0; rep < REPS(k); ++rep) { if (rep) xcd_barrier(bar); __VA_ARGS__ } SEAM(k)
#ifndef MK_DOWN_WGM
#define MK_DOWN_WGM 4
#endif
#ifndef MK_OUT_WGM
#define MK_OUT_WGM 4
#endif
#define GEMM_WGM 8
#define GEMM_PHASE(EPI, ALIGN, A_, BT_, N_, K_, LDA_, LDB_, AGRP_, ...) { pg8::Gemm g{A_, BT_, M, N_, K_, LDA_, LDB_, AGRP_}; pg8::StaticOrder S; S.init(M, N_, G, (int)blockIdx.x); S.wgm = GEMM_WGM; S.pair = (GEMM_WGM == 4 && G == 256) ? 1 : 0; \
        pg8::EPI E{__VA_ARGS__}; pg8::gemm_phase<pg8::EPI, pg8::StaticOrder, ALIGN, PG8_SP2>(lds + RING_OFF, g, S, E); }
    PHASE(0, p0_prologue(P, lds, gw, NGW, wave, lane););
    PHASE(1, GEMM_PHASE(EpiInProj, PG8_ALIGN, XB, (const bf16*)(ws + WS_WINT), LDH, D, D, D, 0, HQ, M, (const float*)(ws + WS_COS), (const float*)(ws + WS_SIN)));
    PHASE(2, compress_phase(P, lds, gw, NGW, wave, lane););
#ifndef MK_DIAG
#define MK_DIAG 0
#endif
#ifndef MK_DUP_ATT
#define MK_DUP_ATT 3
#endif
    if (IN(3)) { if (MK_DIAG == 1) { v4u* z = (v4u*)OC; for (size_t i = (size_t)blockIdx.x * 512 + tid; i < (size_t)M * D * 2 / 16; i += (size_t)G * 512) z[i] = (v4u){0u, 0u, 0u, 0u}; }
        else for (int rep = 0; rep < REPS(3); ++rep) { if (rep) xcd_barrier(bar); at::attention_phase(P, lds, ctl + 8192 * rep, tid, wave, lane, rep ? MK_DUP_ATT : 3); } } SEAM(3);
#undef GEMM_WGM
#define GEMM_WGM MK_OUT_WGM
    PHASE(4, GEMM_PHASE(EpiResStats, PG8_ALIGN, OC, (const bf16*)(ws + WS_WOUTT), D, D, D, D, 0, Y, P.x, nullptr, nullptr, nullptr, nullptr, D, ALPHA));
#undef GEMM_WGM
#define GEMM_WGM 8
    PHASE(5, ln_light(Y, STATS, XB, gw, NGW, lane); finalize_cols((const float*)(ws + WS_COLP), COLS, (float*)(ws + WS_RPART), P.conv_w, P.conv_b, gw, NGW, lane););
    PHASE(6, GEMM_PHASE(EpiUpConv, true, XB, (const bf16*)(ws + WS_WUP0T), NUP, D, D, D, 0, A2, (const float*)(ws + WS_RPART), HALO, lds + XCH_OFF, DFF, NUP));
    PHASE(7, conv_fix(HALO, COLS, P.conv_w, P.conv_b, A2, G, tid););
#undef GEMM_WGM
#define GEMM_WGM MK_DOWN_WGM
    PHASE(8, GEMM_PHASE(EpiResStats, PG8_ALIGN, A2, (const bf16*)(ws + WS_WDN0T), D, DFF, DFF, DFF, 0, Y, nullptr, STATS, P.ln_mix_g, P.ln_mix_b, nullptr, D, ALPHA));
#undef GEMM_WGM
#define GEMM_WGM 8
    PHASE(10, pool_diff(Y, STATS, P.ln_ffn_g, XB, (LAS float*)(lds + RING_OFF), G, tid, wave, lane););
#undef GEMM_WGM
#define GEMM_WGM MK_OUT_WGM
    PHASE(11, GEMM_PHASE(EpiResStats, PG8_ALIGN, XB, (const bf16*)(ws + WS_WPOOLT), D, 1024, D, 1024, 4, Y, nullptr, STATS, P.ln_ffn_g, P.ln_ffn_b, P.pool_scale, D, ALPHA));
#undef GEMM_WGM
#define GEMM_WGM 8
    PHASE(12, ln_light(Y, STATS, XB, gw, NGW, lane););
    PHASE(13, GEMM_PHASE(EpiUpConv, true, XB, (const bf16*)(ws + WS_WUP1T), NUP, D, D, D, 0, A2, (const float*)(ws + WS_RPART) + (size_t)(NUP / 256) * 4 * 64 * 4, HALO, lds + XCH_OFF, DFF, NUP));
    PHASE(14, conv_fix(HALO, COLS + (size_t)3 * NUP, P.conv_w + (size_t)3 * NUP, P.conv_b + NUP, A2, G, tid););
#undef GEMM_WGM
#define GEMM_WGM MK_DOWN_WGM
    PHASE(15, GEMM_PHASE(EpiResStats, PG8_ALIGN, A2, (const bf16*)(ws + WS_WDN1T), D, DFF, DFF, DFF, 0, Y, nullptr, STATS, P.ln_mix_g + D, P.ln_mix_b + D, nullptr, D, ALPHA));
#undef GEMM_WGM
#define GEMM_WGM 8
    if (IN(16)) for (int rep = 0; rep < REPS(16); ++rep) { if (rep) xcd_barrier(bar); ln_rows(Y, P.ln_ffn_g + D, P.ln_ffn_b + D, P.out, nullptr, gw, NGW, lane); }
#undef PHASE
#undef GEMM_PHASE
#undef IN
#undef SEAM
}

extern "C" void kernel_launch(void* const* d_in, const int* in_sizes, int n_in, void* d_out, int out_size, void* d_ws, size_t ws_size, hipStream_t stream) {
    static int grid = 0;
    if (grid == 0) {
        if (n_in != 17 || in_sizes[0] != M * D || out_size != M * D || ws_size < WS_END) { fprintf(stderr, "kernel_launch: built for 17 inputs, x/out of %d floats, >= %zu bytes of workspace; got n_in %d, in0 %d, out %d, ws %zu; nothing launched\n", M * D, (size_t)WS_END, n_in, n_in > 0 ? in_sizes[0] : -1, out_size, ws_size); grid = -1; return; }
        int dev = 0, cus = 0, per_cu = 0;
        if (hipGetDevice(&dev) != hipSuccess || hipDeviceGetAttribute(&cus, hipDeviceAttributeMultiprocessorCount, dev) != hipSuccess) { fprintf(stderr, "kernel_launch: hipGetDevice / hipDeviceGetAttribute failed\n"); grid = -1; return; }
        if (hipFuncSetAttribute((const void*)fwd_kernel, hipFuncAttributeMaxDynamicSharedMemorySize, LDS_BYTES) != hipSuccess) { fprintf(stderr, "kernel_launch: hipFuncSetAttribute(%d B LDS) failed\n", LDS_BYTES); grid = -1; return; }
        if (hipOccupancyMaxActiveBlocksPerMultiprocessor(&per_cu, (const void*)fwd_kernel, NWAVES * 64, LDS_BYTES) != hipSuccess || per_cu < 1)
            fprintf(stderr, "kernel_launch: note: occupancy query reports %d workgroups per CU\n", per_cu);
        (void)hipGetLastError();
        grid = cus;
    }
    if (grid < 0) return;
    if (hipMemsetAsync((char*)d_ws + WS_CTL, 0, CTL_ZERO_BYTES, stream) != hipSuccess) { fprintf(stderr, "kernel_launch: hipMemsetAsync failed\n"); return; }
    Args a{};
    for (int i = 0; i < 17; ++i) a.in[i] = (const float*)d_in[i];
    a.out = (float*)d_out; a.ws = (unsigned char*)d_ws;
#if MK_PER_PHASE
    for (int ph = 0; ph < N_PHASES; ++ph) { a.ph_lo = ph; a.ph_hi = ph + 1;
        hipLaunchKernelGGL(fwd_kernel, dim3(grid), dim3(NWAVES * 64), LDS_BYTES, stream, a); }
#else
    a.ph_lo = 0; a.ph_hi = N_PHASES;
    hipLaunchKernelGGL(fwd_kernel, dim3(grid), dim3(NWAVES * 64), LDS_BYTES, stream, a);
#endif
    const hipError_t le = hipPeekAtLastError();
    if (le != hipSuccess) fprintf(stderr, "kernel_launch: launch failed: %s (grid %d x %d threads, %d B LDS)\n", hipGetErrorName(le), grid, NWAVES * 64, LDS_BYTES);
}
```

```cpp
#include <hip/hip_runtime.h>
#include <cstdio>
#include <cstdint>
namespace pg8 {
#define PG8_LAS __attribute__((address_space(3)))
typedef unsigned short bf16_t;
typedef short bf16x8 __attribute__((ext_vector_type(8)));
typedef float f32x4 __attribute__((ext_vector_type(4)));
typedef unsigned u32x4 __attribute__((ext_vector_type(4)));
typedef _Float16 h8 __attribute__((ext_vector_type(8)));
typedef _Float16 h4 __attribute__((ext_vector_type(4)));
constexpr int BM = 256, BK = 64, HALF = 128, HTB = HALF * BK * 2  , STAGE_BYTES = 8 * HTB, NXCD = 8, WGM = 8;

__host__ __device__ __forceinline__ int lds_byte(int r, int c) { const int st = (r >> 4) * 2 + (c >> 5), rr = r & 15, cc = c & 31, ob = rr * 64 + cc * 2; return st * 1024 + (ob ^ (((ob >> 9) & 1) << 5)); }
__host__ __device__ __forceinline__ void stage_rc(int b, int& R, int& C) { const int st = b / 1024, sb = b % 1024, swz = sb ^ (((sb >> 9) & 1) << 5); R = (st >> 1) * 16 + swz / 64; C = (st & 1) * 32 + (swz % 64) / 2; }
__host__ __device__ __forceinline__ int perm32(int rho) { const int n = rho >> 4, i = rho & 15; return 8 * (i >> 2) + 4 * n + (i & 3); }

struct Unit { int pm, pn; };
struct Gemm { const bf16_t* A; const bf16_t* Bt; int M, N, K, lda, ldb, agrp; };

struct StaticOrder {
    int nM, nN, nwg, G, c, wgm, pair;
    __host__ __device__ void init(int M, int N, int G_, int c_) { nM = M / BM; nN = N / BM; nwg = nM * nN; G = G_; c = c_; wgm = WGM; pair = 0; }
    __host__ __device__ bool next(int i, Unit& u) const {
        const long L = (long)i * G + c; if (L >= nwg) return false;
        if (pair && nN == 16 && (nM & 15) == 0 && nwg == 128 * NXCD) {
            const int xcd = (int)(L % NXCD), off = (int)(L / NXCD), j = xcd >> 1, half = xcd & 1, r = off >> 5, idx = off & 31;
            u.pm = 16 * j + 4 * r + (idx & 3); u.pn = 8 * half + (idx >> 2); return true; }
        int wgid = (int)L; { const int q = nwg / NXCD, r = nwg % NXCD, xcd = wgid % NXCD, off = wgid / NXCD; wgid = (xcd < r ? xcd * (q + 1) : r * (q + 1) + (xcd - r) * q) + off; }
        const int nig = wgm * nN, gid = wgid / nig, fm = gid * wgm, gsz = (nM - fm) < wgm ? (nM - fm) : wgm;
        u.pm = fm + ((wgid % nig) % gsz); u.pn = (wgid % nig) / gsz; return true;
    }
    __device__ __forceinline__ void a_ready(const Unit&) const {}
    __device__ __forceinline__ void done(const Unit&) const {}
};

__device__ __forceinline__ unsigned cvt_pk_bf16(float lo, float hi) { unsigned r; asm volatile("v_cvt_pk_bf16_f32 %0, %1, %2" : "=v"(r) : "v"(lo), "v"(hi)); return r; }
typedef float f32x2 __attribute__((ext_vector_type(2)));
__device__ __forceinline__ f32x2 gelu_pk(f32x2 v) {
    const f32x2 av = __builtin_elementwise_abs(v), d = av * 0.2316418882f + 1.0f;
    f32x2 t; t.x = __builtin_amdgcn_rcpf(d.x); t.y = __builtin_amdgcn_rcpf(d.y);
    f32x2 q = t * 0.5307027145f + (-0.7265760135f); q = q * t + 0.7107068705f; q = q * t + (-0.142248368f); q = q * t + 0.127414796f; q = q * t;
    const f32x2 s = (v * v) * (-0.72134752044f);
    f32x2 e; e.x = __builtin_amdgcn_exp2f(s.x); e.y = __builtin_amdgcn_exp2f(s.y);
    const f32x2 m = v * (q * e), r = v - m;
    f32x2 o; o.x = v.x < 0.f ? m.x : r.x; o.y = v.y < 0.f ? m.y : r.y; return o;
}

template <int ACT  > struct EpiBf16 {
    struct Pre {}; __device__ __forceinline__ void preload(const Unit&, Pre&, int, int) const {}
    static constexpr bool PERM = true, AFTER_DRAIN = false, APERM = false; static_assert(ACT == 0 || ACT == 1, "EpiBf16: ACT is 0 (none) or 1 (gelu_pk)");
    bf16_t* O; int ldc; const float* bias; int split_cols; size_t split_stride; float scale0;
    __device__ __forceinline__ void operator()(const f32x4 (&acc)[2][2][4][2], const Unit& u, int wr, int wc, int fr, int fq, const Pre&) const {
        const int row0 = u.pm * BM + wr * 64 + fr; int colt = u.pn * BM; bf16_t* base = O;
        float sc = 1.f; if (split_cols) { const int t = colt / split_cols; base += (size_t)t * split_stride; colt -= t * split_cols; if (t == 0) sc = scale0; }
        const int col0 = colt + wc * 32 + 8 * fq, bcol0 = u.pn * BM + wc * 32 + 8 * fq;
        f32x4 bv[2][2];
#pragma unroll
        for (int bj = 0; bj < 2; ++bj)
#pragma unroll
            for (int n = 0; n < 2; ++n) bv[bj][n] = bias ? *(const f32x4*)(bias + bcol0 + bj * HALF + 4 * n) : (f32x4){0.f, 0.f, 0.f, 0.f};
#pragma unroll
        for (int ai = 0; ai < 2; ++ai)
#pragma unroll
            for (int m = 0; m < 4; ++m) { bf16_t* rowp = base + (size_t)(row0 + ai * HALF + m * 16) * ldc + col0;
#pragma unroll
                for (int bj = 0; bj < 2; ++bj) { f32x4 v0 = acc[ai][bj][m][0] + bv[bj][0], v1 = acc[ai][bj][m][1] + bv[bj][1];
                    if (ACT == 1) { f32x2 a = gelu_pk((f32x2){v0[0], v0[1]}), b = gelu_pk((f32x2){v0[2], v0[3]}), c = gelu_pk((f32x2){v1[0], v1[1]}), d = gelu_pk((f32x2){v1[2], v1[3]});
                        v0 = (f32x4){a.x, a.y, b.x, b.y}; v1 = (f32x4){c.x, c.y, d.x, d.y}; }
                    v0 = v0 * sc; v1 = v1 * sc; u32x4 w; w.x = cvt_pk_bf16(v0[0], v0[1]); w.y = cvt_pk_bf16(v0[2], v0[3]); w.z = cvt_pk_bf16(v1[0], v1[1]); w.w = cvt_pk_bf16(v1[2], v1[3]);
                    *(u32x4*)(rowp + bj * HALF) = w; } }
    }
};

struct EpiInProj {
    struct Pre {}; __device__ __forceinline__ void preload(const Unit&, Pre&, int, int) const {}
    static constexpr bool PERM = true, AFTER_DRAIN = false, APERM = false;
    bf16_t* O; int mrows; const float* cs; const float* sn;
    static __device__ __forceinline__ bool is_rope(int hb) { return (hb < 16) || (hb >= 24 && hb < 28) || (hb >= 32 && hb < 36); }
    __device__ __forceinline__ void operator()(const f32x4 (&acc)[2][2][4][2], const Unit& u, int wr, int wc, int fr, int fq, const Pre&) const {
        const int row0 = u.pm * BM + wr * 64 + fr, pcol = wc * 32 + 8 * fq, i0 = 4 * (4 * wc + fq);
        const bool rp0 = is_rope(2 * u.pn), rp1 = is_rope(2 * u.pn + 1);
        f32x4 cc[2][4], ss[2][4];
#pragma unroll
        for (int ai = 0; ai < 2; ++ai)
#pragma unroll
            for (int m = 0; m < 4; ++m) { cc[ai][m] = (f32x4){1.f, 1.f, 1.f, 1.f}; ss[ai][m] = (f32x4){0.f, 0.f, 0.f, 0.f}; }
        if (rp0 || rp1) {
#pragma unroll
            for (int ai = 0; ai < 2; ++ai)
#pragma unroll
                for (int m = 0; m < 4; ++m) { const int t = (row0 + ai * HALF + m * 16) & 2047; cc[ai][m] = *(const f32x4*)(cs + t * 64 + i0); ss[ai][m] = *(const f32x4*)(sn + t * 64 + i0); }
            asm volatile("" :: "v"(cc[0][0]), "v"(cc[0][1]), "v"(cc[0][2]), "v"(cc[0][3]), "v"(cc[1][0]), "v"(cc[1][1]), "v"(cc[1][2]), "v"(cc[1][3]),
                               "v"(ss[0][0]), "v"(ss[0][1]), "v"(ss[0][2]), "v"(ss[0][3]), "v"(ss[1][0]), "v"(ss[1][1]), "v"(ss[1][2]), "v"(ss[1][3]) : "memory"); }
#pragma unroll
        for (int ai = 0; ai < 2; ++ai)
#pragma unroll
            for (int m = 0; m < 4; ++m) { const int row = row0 + ai * HALF + m * 16;
#pragma unroll
                for (int bj = 0; bj < 2; ++bj) { const int hb = 2 * u.pn + bj; const bool rope = bj ? rp1 : rp0;
                    f32x4 v0 = acc[ai][bj][m][0], v1 = acc[ai][bj][m][1];
                    if (rope) { const f32x4 c = cc[ai][m], s = ss[ai][m]; const f32x4 r0 = v0 * c - v1 * s, r1 = v0 * s + v1 * c; v0 = r0; v1 = r1; }
                    u32x4 w; w.x = cvt_pk_bf16(v0[0], v0[1]); w.y = cvt_pk_bf16(v0[2], v0[3]); w.z = cvt_pk_bf16(v1[0], v1[1]); w.w = cvt_pk_bf16(v1[2], v1[3]);
                    *(u32x4*)(O + ((size_t)hb * mrows + row) * HALF + pcol) = w; } }
    }
};
struct EpiResStats {
    struct Pre {}; __device__ __forceinline__ void preload(const Unit&, Pre&, int, int) const {}
    static constexpr bool PERM = true, AFTER_DRAIN = false, APERM = false;
    _Float16* Y; const float* res; const float* stats; const float* lg; const float* lb; const float* cscale; int ldc; float alpha;
    __device__ __forceinline__ void operator()(const f32x4 (&acc)[2][2][4][2], const Unit& u, int wr, int wc, int fr, int fq, const Pre&) const {
        const int row0 = u.pm * BM + wr * 64 + fr, col0 = u.pn * BM + wc * 32 + 8 * fq;
        f32x4 sv[2][2], gv[2][2], bv[2][2];
#pragma unroll
        for (int bj = 0; bj < 2; ++bj)
#pragma unroll
            for (int n = 0; n < 2; ++n) { const int c = col0 + bj * HALF + 4 * n; sv[bj][n] = cscale ? *(const f32x4*)(cscale + c) : (f32x4){1.f, 1.f, 1.f, 1.f};
                gv[bj][n] = stats ? *(const f32x4*)(lg + c) : (f32x4){1.f, 1.f, 1.f, 1.f}; bv[bj][n] = stats ? *(const f32x4*)(lb + c) : (f32x4){0.f, 0.f, 0.f, 0.f}; }
        const unsigned e0 = (unsigned)(row0 * ldc + col0), estep = (unsigned)(16 * ldc);
#pragma unroll
        for (int ai = 0; ai < 2; ++ai) {
            if (stats) {
#pragma unroll
              for (int mb = 0; mb < 4; mb += 2) { h8 yv[2][2]; float mu[2], rs[2];
#pragma unroll
                for (int m = 0; m < 2; ++m) { const unsigned row = (unsigned)(row0 + ai * HALF + (mb + m) * 16), off = e0 + (unsigned)(ai * 8 + mb + m) * estep;
                    yv[m][0] = *(const h8*)(Y + off); yv[m][1] = *(const h8*)(Y + (off + HALF)); mu[m] = stats[2 * row]; rs[m] = stats[2 * row + 1]; }
                asm volatile("" :: "v"(yv[0][0]), "v"(yv[0][1]), "v"(yv[1][0]), "v"(yv[1][1]), "v"(mu[0]), "v"(mu[1]), "v"(rs[0]), "v"(rs[1]) : "memory");
#pragma unroll
                for (int m = 0; m < 2; ++m) { const unsigned off = e0 + (unsigned)(ai * 8 + mb + m) * estep;
#pragma unroll
                    for (int bj = 0; bj < 2; ++bj) { const h8 y = yv[m][bj];
                        f32x4 r0 = (f32x4){(float)y[0], (float)y[1], (float)y[2], (float)y[3]}, r1 = (f32x4){(float)y[4], (float)y[5], (float)y[6], (float)y[7]};
                        r0 = (r0 - mu[m]) * rs[m] * gv[bj][0] + bv[bj][0]; r1 = (r1 - mu[m]) * rs[m] * gv[bj][1] + bv[bj][1];
                        const f32x4 o0 = r0 * alpha + acc[ai][bj][mb + m][0] * sv[bj][0], o1 = r1 * alpha + acc[ai][bj][mb + m][1] * sv[bj][1];
                        h8 w; w[0] = (_Float16)o0[0]; w[1] = (_Float16)o0[1]; w[2] = (_Float16)o0[2]; w[3] = (_Float16)o0[3]; w[4] = (_Float16)o1[0]; w[5] = (_Float16)o1[1]; w[6] = (_Float16)o1[2]; w[7] = (_Float16)o1[3];
                        *(h8*)(Y + (off + bj * HALF)) = w; } }
                asm volatile("" ::: "memory"); } }
            else {
#pragma unroll
              for (int mb = 0; mb < 4; mb += 2) { f32x4 rv[2][2][2];
#pragma unroll
                for (int m = 0; m < 2; ++m) { const unsigned off = e0 + (unsigned)(ai * 8 + mb + m) * estep;
#pragma unroll
                    for (int bj = 0; bj < 2; ++bj) { rv[m][bj][0] = *(const f32x4*)(res + (off + bj * HALF)); rv[m][bj][1] = *(const f32x4*)(res + (off + bj * HALF + 4)); } }
                asm volatile("" :: "v"(rv[0][0][0]), "v"(rv[0][0][1]), "v"(rv[0][1][0]), "v"(rv[0][1][1]), "v"(rv[1][0][0]), "v"(rv[1][0][1]), "v"(rv[1][1][0]), "v"(rv[1][1][1]) : "memory");
#pragma unroll
                for (int m = 0; m < 2; ++m) { const unsigned off = e0 + (unsigned)(ai * 8 + mb + m) * estep;
#pragma unroll
                    for (int bj = 0; bj < 2; ++bj) {
                        const f32x4 o0 = rv[m][bj][0] * alpha + acc[ai][bj][mb + m][0] * sv[bj][0], o1 = rv[m][bj][1] * alpha + acc[ai][bj][mb + m][1] * sv[bj][1];
                        h8 w; w[0] = (_Float16)o0[0]; w[1] = (_Float16)o0[1]; w[2] = (_Float16)o0[2]; w[3] = (_Float16)o0[3]; w[4] = (_Float16)o1[0]; w[5] = (_Float16)o1[1]; w[6] = (_Float16)o1[2]; w[7] = (_Float16)o1[3];
                        *(h8*)(Y + (off + bj * HALF)) = w; } }
                asm volatile("" ::: "memory"); } } }
    }
};
struct EpiUpConv {
    static constexpr bool PERM = true, AFTER_DRAIN = false, APERM = true;
    bf16_t* A2; const float* pk; float* halo; PG8_LAS unsigned char* xch; int dff, nup;
    struct Pre { f32x4 v; };
    __device__ __forceinline__ void preload(const Unit& u, Pre& p, int wc, int lane) const { p.v = *(const f32x4*)(pk + ((size_t)(u.pn * 4 + wc) * 64 + lane) * 4); }
    static __device__ __forceinline__ float shr1(float cur, float first) { return __int_as_float(__builtin_amdgcn_update_dpp(__float_as_int(first), __float_as_int(cur), 0x111, 0xf, 0xf, false)); }
    __device__ __forceinline__ void operator()(const f32x4 (&acc_)[2][2][4][2], const Unit& u, int wr, int wc, int fr, int fq, const Pre& pre) const {
        typedef unsigned u32x2 __attribute__((ext_vector_type(2)));
        const f32x4 (&acc)[2][2][4][2] = acc_;
        const int cl = wc * 32 + 8 * fq, f0 = u.pn * 128 + cl;
        PG8_LAS unsigned char* pblk = xch + 6144 + (wr * 4 + wc) * 1024;
        *(PG8_LAS f32x4*)(pblk + (fr + 16 * fq) * 16) = pre.v;
#pragma unroll
        for (int ai = 0; ai < 2; ++ai) { const int ch = 2 * ai + wr;
            if (fr == 15) {
#pragma unroll
                for (int mm = 0; mm < 2; ++mm)
#pragma unroll
                    for (int bj = 0; bj < 2; ++bj)
#pragma unroll
                        for (int n = 0; n < 2; ++n) { const f32x4 v = acc[ai][bj][2 + mm][n];
                            if (ch < 3) *(PG8_LAS f32x4*)(xch + ((ch * 2 + mm) * 256 + bj * 128 + cl + 4 * n) * 4) = v;
                            else *(f32x4*)(halo + (size_t)(u.pm * 4 + 2 + mm) * nup + u.pn * 256 + bj * 128 + cl + 4 * n) = v; } }
            if (ch == 0 && fr == 0) {
#pragma unroll
                for (int mm = 0; mm < 2; ++mm)
#pragma unroll
                    for (int bj = 0; bj < 2; ++bj)
#pragma unroll
                        for (int n = 0; n < 2; ++n) *(f32x4*)(halo + (size_t)(u.pm * 4 + mm) * nup + u.pn * 256 + bj * 128 + cl + 4 * n) = acc[0][bj][mm][n]; } }
        asm volatile("s_waitcnt lgkmcnt(0)" ::: "memory"); __builtin_amdgcn_s_barrier(); asm volatile("" ::: "memory");
        u32x2 keep[2][4];
#pragma unroll
        for (int n = 0; n < 2; ++n) {
            f32x4 W[3][2];
#pragma unroll
            for (int bj = 0; bj < 2; ++bj)
#pragma unroll
                for (int k = 0; k < 3; ++k) W[k][bj] = *(const PG8_LAS f32x4*)(pblk + (fq * 16 + (bj * 2 + n) * 4 + k) * 16);
            f32x4 bbv[2];
#pragma unroll
            for (int bj = 0; bj < 2; ++bj) bbv[bj] = *(const PG8_LAS f32x4*)(pblk + (fq * 16 + (bj * 2 + n) * 4 + 3) * 16);
#pragma unroll
            for (int ai = 0; ai < 2; ++ai) { const int ch = 2 * ai + wr; f32x4 hc[2][4];
#pragma unroll
                for (int bj = 0; bj < 2; ++bj) { f32x4 q2 = (f32x4){0.f, 0.f, 0.f, 0.f}, q3 = q2;
                    if (ch > 0 && fr == 0) { q2 = *(const PG8_LAS f32x4*)(xch + (((ch - 1) * 2 + 0) * 256 + bj * 128 + cl + 4 * n) * 4); q3 = *(const PG8_LAS f32x4*)(xch + (((ch - 1) * 2 + 1) * 256 + bj * 128 + cl + 4 * n) * 4); }
                    const f32x4 a0 = acc[ai][bj][0][n], a1 = acc[ai][bj][1][n], a2 = acc[ai][bj][2][n], a3 = acc[ai][bj][3][n]; f32x4 p2, p3;
#pragma unroll
                    for (int j = 0; j < 4; ++j) { p2[j] = shr1(a2[j], q2[j]); p3[j] = shr1(a3[j], q3[j]); }
                    const f32x4 bb = bbv[bj];
                    hc[bj][0] = ((bb + p2 * W[0][bj]) + p3 * W[1][bj]) + a0 * W[2][bj];
                    hc[bj][1] = ((bb + p3 * W[0][bj]) + a0 * W[1][bj]) + a1 * W[2][bj];
                    hc[bj][2] = ((bb + a0 * W[0][bj]) + a1 * W[1][bj]) + a2 * W[2][bj];
                    hc[bj][3] = ((bb + a1 * W[0][bj]) + a2 * W[1][bj]) + a3 * W[2][bj]; }
#pragma unroll
                for (int m = 0; m < 4; ++m) { const f32x4 gvp = hc[0][m] * hc[1][m]; f32x4 ex, rc;
#pragma unroll
                    for (int j = 0; j < 4; ++j) ex[j] = __builtin_amdgcn_exp2f(hc[0][m][j]);
                    const f32x4 den = ex + 1.f;
#pragma unroll
                    for (int j = 0; j < 4; ++j) rc[j] = __builtin_amdgcn_rcpf(den[j]);
                    const f32x4 o = gvp * rc;
                    u32x2 wv; wv.x = cvt_pk_bf16(o[0], o[1]); wv.y = cvt_pk_bf16(o[2], o[3]);
                    if (n == 0) keep[ai][m] = wv;
                    else if (!(ch == 0 && fr == 0 && m < 2)) { u32x4 w4; w4.x = keep[ai][m].x; w4.y = keep[ai][m].y; w4.z = wv.x; w4.w = wv.y; *(u32x4*)(A2 + (size_t)(u.pm * BM + ai * HALF + wr * 64 + 4 * fr + m) * dff + f0) = w4; } }
                __builtin_amdgcn_sched_barrier(0); }
            asm volatile("" ::: "memory"); }
    }
};
template <class Epi, class Sched, bool ALIGN_EPI = false, bool SP2 = false>
__device__ __forceinline__ void gemm_phase(PG8_LAS unsigned char* lds, const Gemm g, const Sched& S, const Epi& E) {
    const int tid = threadIdx.x, wid = __builtin_amdgcn_readfirstlane(tid >> 6), lane = tid & 63, wr = wid >> 2, wc = wid & 3, fr = lane & 15, fq = lane >> 4;
    const int K = g.K, nt = K / BK;
    unsigned voffA[2], voffB[2];
#pragma unroll
    for (int i = 0; i < 2; ++i) { int R, C; stage_rc(tid * 16 + i * 8192, R, C); const int Rb = Epi::PERM ? ((R & ~31) + perm32(R & 31)) : R;
        const int Ra = Epi::APERM ? ((R & ~63) + 4 * (R & 15) + ((R >> 4) & 3)) : R; voffA[i] = (unsigned)(Ra * g.lda + C) * 2u; voffB[i] = (unsigned)(Rb * g.ldb + C) * 2u; }
    const size_t kstep = (size_t)(BK * 2);
    const size_t hstepA = (size_t)HALF * g.lda * 2, hstepB = (size_t)HALF * g.ldb * 2;
    const size_t tstepA = 2 * hstepA, tstepB = 2 * hstepB;
    const unsigned ldsw = (unsigned)wid * 1024u;
    const int aoff = lds_byte(wr * 64 + fr, fq * 8), boff = lds_byte(wc * 32 + fr, fq * 8);
#define PG8_SA(b, h) (((b) * 2 + (h)) * HTB)
#define PG8_SB(b, h) ((4 + (b) * 2 + (h)) * HTB)
#define PG8_STAGE(bufoff, gbase, voff) do { _Pragma("unroll") for (int _i = 0; _i < 2; ++_i) \
        __builtin_amdgcn_global_load_lds((const unsigned*)((const char*)(gbase) + (voff)[_i]), (PG8_LAS unsigned*)(lds + (bufoff) + ldsw + _i * 8192), 16, 0, 0); } while (0)
#define PG8_LDA(dst, b, h) do { _Pragma("unroll") for (int m = 0; m < 4; ++m) _Pragma("unroll") for (int k = 0; k < 2; ++k) dst[m][k] = *(const PG8_LAS bf16x8*)(lds + PG8_SA(b, h) + aoff + m * 2048 + k * 1024); } while (0)
#define PG8_LDB(dst, b, h) do { _Pragma("unroll") for (int n = 0; n < 2; ++n) _Pragma("unroll") for (int k = 0; k < 2; ++k) dst[n][k] = *(const PG8_LAS bf16x8*)(lds + PG8_SB(b, h) + boff + n * 2048 + k * 1024); } while (0)
#define PG8_MMA(ai, bj, At, Bt) do { __builtin_amdgcn_s_setprio(1); _Pragma("unroll") for (int m = 0; m < 4; ++m) _Pragma("unroll") for (int n = 0; n < 2; ++n) _Pragma("unroll") for (int k = 0; k < 2; ++k) \
        acc[ai][bj][m][n] = __builtin_amdgcn_mfma_f32_16x16x32_bf16(Bt[n][k], At[m][k], acc[ai][bj][m][n], 0, 0, 0); __builtin_amdgcn_s_setprio(0); } while (0)
#define PG8_WAIT_V(n) asm volatile("s_waitcnt vmcnt(" #n ")" ::: "memory")
#define PG8_WAIT_L(n) asm volatile("s_waitcnt lgkmcnt(" #n ")" ::: "memory")
#define PG8_BAR __builtin_amdgcn_s_barrier()
#define PG8_SCHED __builtin_amdgcn_sched_barrier(0)
    Unit cur, nxt; int ui = 0;
    if (!S.next(0, cur)) return;
    typename Epi::Pre pre; E.preload(cur, pre, wc, lane);
    f32x4 acc[2][2][4][2];
#pragma unroll
    for (int a = 0; a < 2; ++a)
#pragma unroll
        for (int b = 0; b < 2; ++b)
#pragma unroll
            for (int m = 0; m < 4; ++m)
#pragma unroll
                for (int n = 0; n < 2; ++n) acc[a][b][m][n] = (f32x4){0.f, 0.f, 0.f, 0.f};
    bf16x8 At[4][2], B0[2][2], B1[2][2];
    const char* cA = (const char*)g.A + (size_t)cur.pm * tstepA + (g.agrp ? (size_t)(cur.pn / g.agrp) * K * 2 : 0); const char* cB = (const char*)g.Bt + (size_t)cur.pn * tstepB;
    S.a_ready(cur);
    if constexpr (SP2) {
        PG8_STAGE(PG8_SB(0, 0), cB, voffB); PG8_STAGE(PG8_SB(0, 1), cB + hstepB, voffB); PG8_STAGE(PG8_SA(0, 0), cA, voffA); PG8_STAGE(PG8_SA(0, 1), cA + hstepA, voffA);
        if (wr == 1) PG8_BAR;
        PG8_WAIT_V(2); PG8_BAR;
        PG8_STAGE(PG8_SB(1, 0), cB + kstep, voffB); PG8_STAGE(PG8_SA(1, 0), cA + kstep, voffA); PG8_STAGE(PG8_SB(1, 1), cB + hstepB + kstep, voffB);
        PG8_WAIT_V(6); PG8_BAR;
    } else {
        PG8_STAGE(PG8_SB(0, 0), cB, voffB); PG8_STAGE(PG8_SA(0, 0), cA, voffA); PG8_STAGE(PG8_SB(0, 1), cB + hstepB, voffB); PG8_STAGE(PG8_SA(0, 1), cA + hstepA, voffA);
        if (wr == 1) PG8_BAR;
        PG8_WAIT_V(4); PG8_BAR;
        PG8_STAGE(PG8_SB(1, 0), cB + kstep, voffB); PG8_STAGE(PG8_SA(1, 0), cA + kstep, voffA); PG8_STAGE(PG8_SB(1, 1), cB + hstepB + kstep, voffB);
        PG8_WAIT_V(6); PG8_BAR;
    }
    for (;;) {
        const bool has_next = S.next(ui + 1, nxt);
        const char* nA = has_next ? (const char*)g.A + (size_t)nxt.pm * tstepA + (g.agrp ? (size_t)(nxt.pn / g.agrp) * K * 2 : 0) : cA; const char* nB = has_next ? (const char*)g.Bt + (size_t)nxt.pn * tstepB : cB;
        for (int t = 0; t < nt; t += 2) {
            const bool last = (t == nt - 2);
            const char* a1 = cA + (size_t)(t + 1) * kstep;
            const char* a2 = last ? nA : cA + (size_t)(t + 2) * kstep; const char* b2 = last ? nB : cB + (size_t)(t + 2) * kstep;
            const char* a3 = a2 + kstep; const char* b3 = b2 + kstep;
            if (last && has_next) S.a_ready(nxt);
            if constexpr (SP2) {
            PG8_LDB(B0, 0, 0); PG8_LDB(B1, 0, 1); PG8_SCHED; PG8_LDA(At, 0, 0); PG8_STAGE(PG8_SA(1, 1), a1 + hstepA, voffA);
            PG8_WAIT_V(8); PG8_WAIT_L(0); PG8_BAR; PG8_MMA(0, 0, At, B0); PG8_MMA(0, 1, At, B1); PG8_BAR; PG8_SCHED;
            PG8_LDA(At, 0, 1); PG8_STAGE(PG8_SB(0, 0), b2, voffB); PG8_STAGE(PG8_SB(0, 1), b2 + hstepB, voffB); PG8_STAGE(PG8_SA(0, 0), a2, voffA);
            PG8_WAIT_V(8); PG8_WAIT_L(0); PG8_BAR; PG8_MMA(1, 0, At, B0); PG8_MMA(1, 1, At, B1); PG8_BAR; PG8_SCHED;
            PG8_LDB(B0, 1, 0); PG8_LDB(B1, 1, 1); PG8_SCHED; PG8_LDA(At, 1, 0); PG8_STAGE(PG8_SA(0, 1), a2 + hstepA, voffA);
            PG8_WAIT_V(8); PG8_WAIT_L(0); PG8_BAR; PG8_MMA(0, 0, At, B0); PG8_MMA(0, 1, At, B1); PG8_BAR; PG8_SCHED;
            PG8_LDA(At, 1, 1); PG8_STAGE(PG8_SB(1, 0), b3, voffB); PG8_STAGE(PG8_SB(1, 1), b3 + hstepB, voffB); PG8_STAGE(PG8_SA(1, 0), a3, voffA);
            PG8_WAIT_V(8); PG8_WAIT_L(0); PG8_BAR; PG8_MMA(1, 0, At, B0); PG8_MMA(1, 1, At, B1); PG8_BAR; PG8_SCHED;
            } else {
            PG8_LDB(B0, 0, 0); PG8_SCHED; PG8_LDA(At, 0, 0); PG8_STAGE(PG8_SA(1, 1), a1 + hstepA, voffA);
            PG8_WAIT_L(8); PG8_BAR; PG8_WAIT_L(0); PG8_MMA(0, 0, At, B0); PG8_BAR; PG8_SCHED;
            PG8_LDB(B1, 0, 1); PG8_STAGE(PG8_SB(0, 0), b2, voffB);
            PG8_BAR; PG8_WAIT_L(0); PG8_MMA(0, 1, At, B1); PG8_BAR;
            PG8_LDA(At, 0, 1); PG8_STAGE(PG8_SA(0, 0), a2, voffA);
            PG8_BAR; PG8_WAIT_L(0); PG8_MMA(1, 0, At, B0); PG8_BAR; PG8_SCHED;
            PG8_STAGE(PG8_SB(0, 1), b2 + hstepB, voffB);
            PG8_WAIT_V(6); PG8_BAR; PG8_MMA(1, 1, At, B1); PG8_BAR;
            PG8_LDB(B0, 1, 0); PG8_SCHED; PG8_LDA(At, 1, 0); PG8_STAGE(PG8_SA(0, 1), a2 + hstepA, voffA);
            PG8_WAIT_L(8); PG8_BAR; PG8_WAIT_L(0); PG8_MMA(0, 0, At, B0); PG8_BAR; PG8_SCHED;
            PG8_LDB(B1, 1, 1); PG8_STAGE(PG8_SB(1, 0), b3, voffB);
            PG8_BAR; PG8_WAIT_L(0); PG8_MMA(0, 1, At, B1); PG8_BAR;
            PG8_LDA(At, 1, 1); PG8_STAGE(PG8_SA(1, 0), a3, voffA);
            PG8_BAR; PG8_WAIT_L(0); PG8_MMA(1, 0, At, B0); PG8_BAR; PG8_SCHED;
            PG8_STAGE(PG8_SB(1, 1), b3 + hstepB, voffB);
            PG8_WAIT_V(6); PG8_BAR; PG8_MMA(1, 1, At, B1); PG8_BAR;
            }
        }
        if constexpr (ALIGN_EPI) { if (wr == 0) PG8_BAR; }
        if constexpr (!Epi::AFTER_DRAIN) { E(acc, cur, wr, wc, fr, fq, pre); S.done(cur); }
        if (!has_next) break;
#pragma unroll
        for (int a = 0; a < 2; ++a)
#pragma unroll
            for (int b = 0; b < 2; ++b)
#pragma unroll
                for (int m = 0; m < 4; ++m)
#pragma unroll
                    for (int n = 0; n < 2; ++n) acc[a][b][m][n] = (f32x4){0.f, 0.f, 0.f, 0.f};
        cur = nxt; cA = nA; cB = nB; ++ui; E.preload(cur, pre, wc, lane);
        if constexpr (ALIGN_EPI) { if (wr == 1) PG8_BAR; }
    }
    PG8_WAIT_V(0);
    if constexpr (!ALIGN_EPI) { if (wr == 0) PG8_BAR; }
    PG8_BAR;
    if constexpr (Epi::AFTER_DRAIN) { E.fused(acc, cur, wr, wc, fr, fq, lds, wid, lane); S.done(cur); }
#undef PG8_SA
#undef PG8_SB
#undef PG8_STAGE
#undef PG8_LDA
#undef PG8_LDB
#undef PG8_MMA
#undef PG8_WAIT_V
#undef PG8_WAIT_L
#undef PG8_BAR
#undef PG8_SCHED
}
}

#ifndef PG8_SP2
#define PG8_SP2 true
#endif
#ifndef PG8_ALIGN
#define PG8_ALIGN true
#endif
constexpr int NWAVES = 8;
#ifndef MK_PER_PHASE
#define MK_PER_PHASE 0
#endif
constexpr int N_PHASES = 17;

constexpr int BATCH = 8, T = 2048, D = 4096, M = BATCH * T, HD = 128;
constexpr int IN_DIM = 11312, LDH = 11520;
constexpr int C_QA = 0, C_KC = 2048, C_VC = 2560, C_KS = 3072, C_VS = 3584, C_KW = 4096, C_VW = 4608, C_QB = 5120, C_KB = 7168, C_VB = 9216, C_GATE = 11264;
constexpr int DFF = 11008, NUP = 2 * DFF;
constexpr float LN_EPS = 1e-5f, ALPHA = 1.41421356237309515f;

constexpr size_t MiB = 1u << 20;
constexpr size_t WS_CTL = 0, CTL_ZERO_BYTES = 128 * 1024;
constexpr size_t WS_COS = 1 * MiB, WS_SIN = WS_COS + 512 * 1024;
constexpr size_t WS_CK = 2 * MiB, WS_CV = WS_CK + 1024;
constexpr size_t WS_WCKT = 3 * MiB, WS_WCVT = 4 * MiB;
constexpr size_t WS_KC = 5 * MiB, WS_VC = 6 * MiB;
constexpr size_t WS_WPOOLT = 8 * MiB, WS_WOUTT = 16 * MiB, WS_WINT = 48 * MiB, WS_WUP0T = 138 * MiB, WS_WUP1T = 310 * MiB, WS_WDN0T = 482 * MiB, WS_WDN1T = 568 * MiB;
constexpr size_t WS_XB = 654 * MiB;
constexpr size_t WS_X1 = 782 * MiB;
constexpr size_t WS_Y = 1038 * MiB;
constexpr size_t WS_A2 = 1294 * MiB;
constexpr size_t WS_HQ = 1638 * MiB;
constexpr size_t WS_OACC = 1998 * MiB;
constexpr size_t WS_OC = 2126 * MiB;
constexpr size_t WS_H = 1638 * MiB;
constexpr size_t WS_COLP = 2326 * MiB;
constexpr size_t WS_COLS = 2350 * MiB;
constexpr size_t WS_RPART = 2352 * MiB;
constexpr size_t WS_STATS = 2360 * MiB;
constexpr size_t WS_END = 2362 * MiB;
static_assert(WS_WINT + (size_t)LDH * D * 2 <= WS_WUP0T && WS_WUP0T + (size_t)NUP * D * 2 <= WS_WUP1T && WS_WUP1T + (size_t)NUP * D * 2 <= WS_WDN0T && WS_WDN0T + (size_t)D * DFF * 2 <= WS_WDN1T && WS_WDN1T + (size_t)D * DFF * 2 <= WS_XB, "ws map 1");
static_assert(WS_XB + (size_t)M * D * 2 <= WS_X1 && WS_X1 + (size_t)M * D * 4 <= WS_Y && WS_Y + (size_t)M * D * 4 <= WS_A2 && WS_A2 + (size_t)M * DFF * 2 <= WS_HQ && WS_HQ + (size_t)M * LDH * 2 <= WS_OACC && WS_OACC + (size_t)M * 2048 * 4 <= WS_OC && WS_OC + (size_t)M * D * 2 <= WS_COLP && WS_H + (size_t)(M / 256) * 4 * NUP * 4 <= WS_OACC && WS_COLP + (size_t)2 * 64 * NUP * 8 <= WS_COLS && WS_COLS + (size_t)2 * NUP * 8 <= WS_RPART && WS_RPART + (size_t)M * 64 * 8 <= WS_STATS && WS_STATS + (size_t)M * 8 <= WS_END, "ws map 2");
constexpr int CW_BAR = 4096;
constexpr int CW_QNSA = 8192, CW_QSB = 8192 + 1024;

constexpr int RING_OFF = 0, RING_BYTES = 131072;
constexpr int MISC_OFF = RING_BYTES;
constexpr int XCH_OFF = RING_BYTES + 256;
constexpr int LDS_BYTES = 147456;

#define LAS __attribute__((address_space(3)))
typedef unsigned short bf16;
typedef unsigned v4u __attribute__((ext_vector_type(4)));
typedef unsigned v2u __attribute__((ext_vector_type(2)));
typedef float f32x4 __attribute__((ext_vector_type(4)));
typedef float f32x16 __attribute__((ext_vector_type(16)));
typedef short bf16x8 __attribute__((ext_vector_type(8)));
typedef short s16x4 __attribute__((ext_vector_type(4)));
typedef _Float16 h8 __attribute__((ext_vector_type(8)));
typedef _Float16 h4 __attribute__((ext_vector_type(4)));
__device__ __forceinline__ f32x4 ld4h(const _Float16* p) { const h4 y = *(const h4*)p; return (f32x4){(float)y[0], (float)y[1], (float)y[2], (float)y[3]}; }
__device__ __forceinline__ void load_row_h(const _Float16* yrow, int lane, f32x4 (&v)[16]) {
#pragma unroll
    for (int j = 0; j < 8; ++j) { const h8 y = *((const h8*)yrow + lane + 64 * j); v[2 * j] = (f32x4){(float)y[0], (float)y[1], (float)y[2], (float)y[3]}; v[2 * j + 1] = (f32x4){(float)y[4], (float)y[5], (float)y[6], (float)y[7]}; }
}
#define LDS_WAIT() asm volatile("s_waitcnt lgkmcnt(0)" ::: "memory")
#define VM_WAIT() asm volatile("s_waitcnt vmcnt(0)" ::: "memory")
__device__ __forceinline__ unsigned cvtpk(float lo, float hi) { unsigned r; asm volatile("v_cvt_pk_bf16_f32 %0, %1, %2" : "=v"(r) : "v"(lo), "v"(hi)); return r; }
__device__ __forceinline__ float bf2f(unsigned short b) { return __uint_as_float(((unsigned)b) << 16); }
__device__ __forceinline__ float wave_sum(float v) {
#pragma unroll
    for (int o = 1; o < 64; o <<= 1) v += __shfl_xor(v, o);
    return v;
}
#define XB_TMO      128
#define XB_XCNT(j)  (256  + 64 * (j))
#define XB_XSUB(j)  (1280 + 64 * (j))
#define XB_XGEN(j)  (2304 + 64 * (j))
#define XB_TOP      3328
#define XB_TOPGEN   3392
#define XCD_BAR_WORDS 3456
#define XB_SPIN_CAP (1u << 18)

__device__ __forceinline__ unsigned xb_ld(unsigned* p)              { return __hip_atomic_load(p, __ATOMIC_RELAXED, __HIP_MEMORY_SCOPE_AGENT); }
__device__ __forceinline__ unsigned xb_add(unsigned* p, unsigned v) { return __hip_atomic_fetch_add(p, v, __ATOMIC_RELAXED, __HIP_MEMORY_SCOPE_AGENT); }
__device__ __forceinline__ unsigned xb_xcc_id() { return (unsigned)__builtin_amdgcn_s_getreg((3 << 11) | 20) & 0xFu; }
#define XB_SPIN(cond, bar) do { unsigned _sp = 0; while (cond) { __builtin_amdgcn_s_sleep(1); \
    if ((++_sp & 255u) == 0u) { if (xb_ld(&(bar)[XB_TMO])) break; if (_sp > XB_SPIN_CAP) { atomicAdd(&(bar)[XB_TMO], 1u); break; } } } } while (0)

struct XcdBarrier {
    unsigned* bar; unsigned x;
    volatile LAS unsigned* st;
};

__device__ __forceinline__ XcdBarrier xcd_barrier_post(unsigned* bar, volatile LAS unsigned* st) {
    XcdBarrier b; b.bar = bar; b.x = xb_xcc_id(); b.st = st;
    if (threadIdx.x == 0) (void)xb_add(&bar[XB_XCNT(b.x)], 1u);
    return b;
}
__device__ __forceinline__ void xcd_barrier_complete(unsigned* bar, unsigned x, unsigned& nloc, unsigned& nx) {
    const unsigned G = gridDim.x * gridDim.y * gridDim.z;
    unsigned sum, cnt, mine, sp = 0u;
    for (;;) {
        sum = 0u; cnt = 0u; mine = 0u;
#pragma unroll
        for (unsigned j = 0; j < 16; ++j) { const unsigned c = xb_ld(&bar[XB_XCNT(j)]); sum += c; cnt += (c > 0u) ? 1u : 0u; mine = (j == x) ? c : mine; }
        if (sum == G) break;
        __builtin_amdgcn_s_sleep(1);
        if ((++sp & 255u) == 0u) { if (xb_ld(&bar[XB_TMO])) break; if (sp > XB_SPIN_CAP) { atomicAdd(&bar[XB_TMO], 1u); break; } }
    }
    nloc = mine > 0u ? mine : 1u; nx = cnt > 0u ? cnt : 1u;
}

__device__ __forceinline__ void xcd_barrier(const XcdBarrier& b) {
    asm volatile("s_waitcnt vmcnt(0)" ::: "memory");
    __syncthreads();
    if (threadIdx.x == 0) {
        unsigned* bar = b.bar;
        __builtin_amdgcn_s_waitcnt(0);
        unsigned nloc = b.st[0], nx = b.st[1];
        if (nloc == 0u) { xcd_barrier_complete(bar, b.x, nloc, nx); b.st[0] = nloc; b.st[1] = nx; }
        const unsigned old = xb_add(&bar[XB_XSUB(b.x)], 1u);
        const unsigned gen = old / nloc;
        if (old + 1u == (gen + 1u) * nloc) {
            __builtin_amdgcn_fence(__ATOMIC_RELEASE, "agent");
            asm volatile("s_waitcnt vmcnt(0)" ::: "memory");
            const unsigned og = xb_add(&bar[XB_TOP], 1u);
            const unsigned tg = og / nx;
            if (og + 1u == (tg + 1u) * nx) xb_add(&bar[XB_TOPGEN], 1u);
            else XB_SPIN(xb_ld(&bar[XB_TOPGEN]) == tg, bar);
            __builtin_amdgcn_fence(__ATOMIC_ACQUIRE, "agent");
            xb_add(&bar[XB_XGEN(b.x)], 1u);
            asm volatile("s_waitcnt vmcnt(0)" ::: "memory");
        } else {
            XB_SPIN(xb_ld(&bar[XB_XGEN(b.x)]) == gen, bar);
            __builtin_amdgcn_fence(__ATOMIC_ACQUIRE, "agent");
            asm volatile("s_waitcnt vmcnt(0)" ::: "memory");
        }
    }
    __syncthreads();
}

__device__ __forceinline__ int inproj_phys(int L) {
    int P = L < 5120 ? L : (L < 5168 ? C_GATE + (L - 5120) : L - 48);
    const int hb = P >> 7;
    if ((hb < 16) || (hb >= 24 && hb < 28) || (hb >= 32 && hb < 36)) { const int d = P & 127, n = d >> 6, q = (d >> 2) & 15, j = d & 3; P = (hb << 7) + 8 * q + 4 * n + j; }
    return P;
}
__device__ __forceinline__ int up_phys(int L) { const int bj = L >= DFF ? 1 : 0, f = L - bj * DFF; return (f >> 7) * 256 + bj * 128 + (f & 127); }

struct TrItem { const float* W; bf16* WT; const float* lg; const float* lb; float* colp; int K, N, row_off, map, item; };
__device__ __forceinline__ void tr_load(const TrItem& t, f32x4 (&v)[8], int lane) {
    const int nblk = (t.N + 31) / 32, kb = t.item / nblk, nb = t.item % nblk, k0 = 64 * kb, n0 = 32 * nb, r8 = lane >> 3, c4 = (lane & 7) * 4; const bool inb = n0 + c4 < t.N;
#pragma unroll
    for (int i = 0; i < 8; ++i) v[i] = inb ? *(const f32x4*)(t.W + (size_t)(k0 + 8 * i + r8) * t.N + n0 + c4) : (f32x4){0.f, 0.f, 0.f, 0.f};
}
__device__ __forceinline__ void tr_store(const TrItem& t, const f32x4 (&v)[8], LAS float* scr, int lane) {
    const int K = t.K, N = t.N, nblk = (N + 31) / 32, kb = t.item / nblk, nb = t.item % nblk, k0 = 64 * kb, n0 = 32 * nb, r8 = lane >> 3, c4 = (lane & 7) * 4;
#pragma unroll
    for (int i = 0; i < 8; ++i) { LAS float* d = scr + (8 * i + r8) * 33 + c4; d[0] = v[i][0]; d[1] = v[i][1]; d[2] = v[i][2]; d[3] = v[i][3]; }
    LDS_WAIT(); asm volatile("" ::: "memory");
    const int c = lane & 7;
    f32x4 g0, g1, b0, b1;
    if (t.map == 2) { g0 = *(const f32x4*)(t.lg + k0 + 8 * c); g1 = *(const f32x4*)(t.lg + k0 + 8 * c + 4); b0 = *(const f32x4*)(t.lb + k0 + 8 * c); b1 = *(const f32x4*)(t.lb + k0 + 8 * c + 4); }
#pragma unroll
    for (int j = 0; j < 4; ++j) { const int n = (lane >> 3) + 8 * j; const LAS float* s = scr + (8 * c) * 33 + n;
        float wv[8];
#pragma unroll
        for (int i = 0; i < 8; ++i) wv[i] = s[i * 33];
        v4u o;
        if (t.map == 2) {
            float bs = ((wv[0] * b0[0] + wv[1] * b0[1]) + (wv[2] * b0[2] + wv[3] * b0[3])) + ((wv[4] * b1[0] + wv[5] * b1[1]) + (wv[6] * b1[2] + wv[7] * b1[3]));
            o.x = cvtpk(wv[0] * g0[0], wv[1] * g0[1]); o.y = cvtpk(wv[2] * g0[2], wv[3] * g0[3]); o.z = cvtpk(wv[4] * g1[0], wv[5] * g1[1]); o.w = cvtpk(wv[6] * g1[2], wv[7] * g1[3]);
            float cs = 0.f;
#pragma unroll
            for (int i = 0; i < 4; ++i) cs += __uint_as_float(o[i] << 16) + __uint_as_float(o[i] & 0xffff0000u);
            cs += __shfl_xor(cs, 1); cs += __shfl_xor(cs, 2); cs += __shfl_xor(cs, 4); bs += __shfl_xor(bs, 1); bs += __shfl_xor(bs, 2); bs += __shfl_xor(bs, 4);
            if (c == 0 && n0 + n < N) { float* cp = t.colp + ((size_t)kb * N + up_phys(n0 + n)) * 2; cp[0] = cs; cp[1] = bs; }
        } else { o.x = cvtpk(wv[0], wv[1]); o.y = cvtpk(wv[2], wv[3]); o.z = cvtpk(wv[4], wv[5]); o.w = cvtpk(wv[6], wv[7]); }
        if (n0 + n < N) { const int row = t.map == 1 ? inproj_phys(n0 + n) : (t.map == 2 ? up_phys(n0 + n) : t.row_off + n0 + n);
            *(v4u*)(t.WT + (size_t)row * K + k0 + 8 * c) = o; } }
    LDS_WAIT(); asm volatile("" ::: "memory");
}
__device__ __forceinline__ void sincos_d(double a, double& s, double& c) {
    const double q = rint(a * 0.63661977236758134308);
    double r = fma(-q, 1.57079632679489655800, a); r = fma(-q, 6.12323399573676603587e-17, r);
    const double r2 = r * r;
    const double sp = r * (1.0 + r2 * (-1.0 / 6.0 + r2 * (1.0 / 120.0 + r2 * (-1.0 / 5040.0 + r2 * (1.0 / 362880.0 + r2 * (-1.0 / 39916800.0 + r2 * (1.0 / 6227020800.0 + r2 * (-1.0 / 1307674368000.0))))))));
    const double cp = 1.0 + r2 * (-0.5 + r2 * (1.0 / 24.0 + r2 * (-1.0 / 720.0 + r2 * (1.0 / 40320.0 + r2 * (-1.0 / 3628800.0 + r2 * (1.0 / 479001600.0 + r2 * (-1.0 / 87178291200.0 + r2 * (1.0 / 20922789888000.0))))))));
    const int qi = (int)((long long)q & 3);
    s = (qi == 0) ? sp : (qi == 1) ? cp : (qi == 2) ? -sp : -cp;
    c = (qi == 0) ? cp : (qi == 1) ? -sp : (qi == 2) ? -cp : sp;
}
struct Ptrs {
    const float *x, *w_in, *w_out, *cmp_wk, *cmp_wv, *pe_k, *pe_v, *pool_w, *pool_scale, *w_up, *conv_w, *conv_b, *w_down, *ln_mix_g, *ln_mix_b, *ln_ffn_g, *ln_ffn_b;
    float* out; unsigned char* ws;
};
__device__ __forceinline__ void p0_prologue(const Ptrs& P, LAS unsigned char* lds, int gw, int NGW, int wave, int lane) {
    LAS float* scr = (LAS float*)(lds + RING_OFF + wave * 16384);
    unsigned char* ws = P.ws;
    constexpr int I_IN = (D / 64) * ((IN_DIM + 31) / 32), I_OUT = (D / 64) * (D / 32), I_UP = (D / 64) * (NUP / 32), I_DN = (DFF / 64) * (D / 32), I_POOL = (1024 / 64) * (1024 / 32), I_CMP = (4096 / 64) * (128 / 32);
    constexpr int NITEMS = I_IN + I_OUT + 2 * I_UP + 2 * I_DN + 4 * I_POOL + 2 * I_CMP;
    auto decode = [&](int it) -> TrItem { TrItem t; t.lg = nullptr; t.lb = nullptr; t.colp = nullptr; t.row_off = 0; t.map = 0; int r = it;
        if (r < I_UP) { t.W = P.w_up; t.WT = (bf16*)(ws + WS_WUP0T); t.K = D; t.N = NUP; t.map = 2; t.lg = P.ln_mix_g; t.lb = P.ln_mix_b; t.colp = (float*)(ws + WS_COLP); t.item = r; return t; } r -= I_UP;
        if (r < I_UP) { t.W = P.w_up + (size_t)D * NUP; t.WT = (bf16*)(ws + WS_WUP1T); t.K = D; t.N = NUP; t.map = 2; t.lg = P.ln_mix_g + D; t.lb = P.ln_mix_b + D; t.colp = (float*)(ws + WS_COLP) + (size_t)64 * NUP * 2; t.item = r; return t; } r -= I_UP;
        if (r < I_IN) { t.W = P.w_in; t.WT = (bf16*)(ws + WS_WINT); t.K = D; t.N = IN_DIM; t.map = 1; t.item = r; return t; } r -= I_IN;
        if (r < I_DN) { t.W = P.w_down; t.WT = (bf16*)(ws + WS_WDN0T); t.K = DFF; t.N = D; t.item = r; return t; } r -= I_DN;
        if (r < I_DN) { t.W = P.w_down + (size_t)DFF * D; t.WT = (bf16*)(ws + WS_WDN1T); t.K = DFF; t.N = D; t.item = r; return t; } r -= I_DN;
        if (r < I_OUT) { t.W = P.w_out; t.WT = (bf16*)(ws + WS_WOUTT); t.K = D; t.N = D; t.item = r; return t; } r -= I_OUT;
        if (r < 4 * I_POOL) { const int g = r / I_POOL; t.W = P.pool_w + (size_t)g * 1024 * 1024; t.WT = (bf16*)(ws + WS_WPOOLT); t.K = 1024; t.N = 1024; t.row_off = g * 1024; t.item = r % I_POOL; return t; } r -= 4 * I_POOL;
        if (r < I_CMP) { t.W = P.cmp_wk; t.WT = (bf16*)(ws + WS_WCKT); t.K = 4096; t.N = 128; t.item = r; return t; } r -= I_CMP;
        t.W = P.cmp_wv; t.WT = (bf16*)(ws + WS_WCVT); t.K = 4096; t.N = 128; t.item = r; return t; };
    if (gw < NITEMS) { TrItem cur = decode(gw); f32x4 va[8], vb[8]; tr_load(cur, va, lane);
        for (int it = gw; it < NITEMS; it += 2 * NGW) {
            const bool h1 = it + NGW < NITEMS; TrItem n1 = cur; if (h1) { n1 = decode(it + NGW); tr_load(n1, vb, lane); }
            tr_store(cur, va, scr, lane);
            if (!h1) break;
            const bool h2 = it + 2 * NGW < NITEMS; if (h2) { cur = decode(it + 2 * NGW); tr_load(cur, va, lane); }
            tr_store(n1, vb, scr, lane);
            if (!h2) break; } }
    { bf16* xb = (bf16*)(ws + WS_XB);
      for (int i = gw; i < M * D / 2048; i += NGW) { f32x4 a[4], b[4];
#pragma unroll
          for (int q = 0; q < 4; ++q) { const size_t e = (size_t)i * 2048 + q * 512 + lane * 8; a[q] = *(const f32x4*)(P.x + e); b[q] = *(const f32x4*)(P.x + e + 4); }
#pragma unroll
          for (int q = 0; q < 4; ++q) { const size_t e = (size_t)i * 2048 + q * 512 + lane * 8; v4u o; o.x = cvtpk(a[q][0], a[q][1]); o.y = cvtpk(a[q][2], a[q][3]); o.z = cvtpk(b[q][0], b[q][1]); o.w = cvtpk(b[q][2], b[q][3]); *(v4u*)(xb + e) = o; } } }
    { float* ct = (float*)(ws + WS_COS); float* st = (float*)(ws + WS_SIN);
      for (int i = gw * 64 + lane; i < T * 64; i += NGW * 64) { const int pos = i >> 6, fi = i & 63; double pw = 1.0; for (int k = 0; k < fi; ++k) pw *= 1.1547819846894583;
          double s, c; sincos_d((double)pos / pw, s, c); ct[i] = (float)c; st[i] = (float)s; } }
    for (int it = gw; it < 256; it += NGW) { const int kv = it >> 7, e = it & 127; const float* pe = kv ? P.pe_v : P.pe_k; const float* W = kv ? P.cmp_wv : P.cmp_wk; float s = 0.f;
        for (int kk = lane; kk < 4096; kk += 64) s += pe[kk] * W[(size_t)kk * 128 + e];
        s = wave_sum(s); if (lane == 0) ((float*)(ws + (kv ? WS_CV : WS_CK)))[e] = s; }
    { v4u* z = (v4u*)((bf16*)(ws + WS_WINT) + (size_t)IN_DIM * D); const int n16 = (LDH - IN_DIM) * D * 2 / 16;
      for (int i = gw * 64 + lane; i < n16; i += NGW * 64) z[i] = (v4u){0u, 0u, 0u, 0u}; }
}

__device__ __forceinline__ void ln_rows(const _Float16* Y, const float* g, const float* b, float* Xo, bf16* Xb, int gw, int NGW, int lane) {
    f32x4 gg[16], bb[16];
#pragma unroll
    for (int j = 0; j < 16; ++j) { const int c = 512 * (j >> 1) + 8 * lane + 4 * (j & 1); gg[j] = *(const f32x4*)(g + c); bb[j] = *(const f32x4*)(b + c); }
    for (int m = gw; m < M; m += NGW) {
        f32x4 v[16]; load_row_h(Y + (size_t)m * D, lane, v); float s = 0.f;
#pragma unroll
        for (int j = 0; j < 16; ++j) s += (v[j].x + v[j].y) + (v[j].z + v[j].w);
        const float mean = wave_sum(s) * (1.f / D); float s2 = 0.f;
#pragma unroll
        for (int j = 0; j < 16; ++j) { v[j] = v[j] - mean; s2 += (v[j].x * v[j].x + v[j].y * v[j].y) + (v[j].z * v[j].z + v[j].w * v[j].w); }
        const float rstd = 1.f / sqrtf(wave_sum(s2) * (1.f / D) + LN_EPS);
#pragma unroll
        for (int j = 0; j < 16; ++j) { const int c = 512 * (j >> 1) + 8 * lane + 4 * (j & 1); const f32x4 o = v[j] * rstd * gg[j] + bb[j];
            if (Xo) *(f32x4*)(Xo + (size_t)m * D + c) = o;
            if (Xb) { v2u w; w.x = cvtpk(o[0], o[1]); w.y = cvtpk(o[2], o[3]); *(v2u*)(Xb + (size_t)m * D + c) = w; } }
    }
}

__device__ __forceinline__ void ln_light(const _Float16* Y, float* stats, bf16* ZB, int gw, int NGW, int lane) {
    for (int m = gw; m < M; m += NGW) {
        f32x4 v[16]; load_row_h(Y + (size_t)m * D, lane, v); float s = 0.f;
#pragma unroll
        for (int j = 0; j < 16; ++j) s += (v[j].x + v[j].y) + (v[j].z + v[j].w);
        const float mean = wave_sum(s) * (1.f / D); float s2 = 0.f;
#pragma unroll
        for (int j = 0; j < 16; ++j) { v[j] = v[j] - mean; s2 += (v[j].x * v[j].x + v[j].y * v[j].y) + (v[j].z * v[j].z + v[j].w * v[j].w); }
        const float rstd = 1.f / sqrtf(wave_sum(s2) * (1.f / D) + LN_EPS);
        if (lane == 0) { stats[2 * m] = mean; stats[2 * m + 1] = rstd; }
        if (ZB) {
#pragma unroll
            for (int j = 0; j < 8; ++j) { const f32x4 a = v[2 * j] * rstd, c = v[2 * j + 1] * rstd; v4u w; w.x = cvtpk(a[0], a[1]); w.y = cvtpk(a[2], a[3]); w.z = cvtpk(c[0], c[1]); w.w = cvtpk(c[2], c[3]);
                *((v4u*)(ZB + (size_t)m * D) + lane + 64 * j) = w; } }
    }
}
__device__ __forceinline__ void finalize_cols(const float* colp, float* cols, float* pk, const float* cw, const float* cb, int gw, int NGW, int lane) {
    for (int i = gw * 64 + lane; i < 2 * NUP; i += NGW * 64) { const int layer = i / NUP, n = i % NUP; const float* cp = colp + ((size_t)layer * 64 * NUP + n) * 2; float cs = 0.f, bs = 0.f;
        for (int kb = 0; kb < 64; ++kb) { cs += cp[(size_t)kb * NUP * 2]; bs += cp[(size_t)kb * NUP * 2 + 1]; }
        const int L = ((n >> 7) & 1) * DFF + (n >> 8) * 128 + (n & 127); const float* w = cw + (size_t)layer * 3 * NUP + L;
        const float cbf = cb[(size_t)layer * NUP + L] + bs * ((w[0] + w[NUP]) + w[2 * NUP]);
        float* c3 = cols + (size_t)layer * 3 * NUP; c3[n] = cs; c3[NUP + n] = bs; c3[2 * NUP + n] = cbf;
        { const int cl = n & 127, bj = (n >> 7) & 1; const float sc = bj ? -0.6931471805599453f : -1.4426950408889634f;
          float* pp = pk + (size_t)layer * (NUP / 256) * 4 * 64 * 4 + ((size_t)(((n >> 8) * 4 + (cl >> 5)) * 64 + ((cl >> 3) & 3) * 16 + (bj * 2 + ((cl >> 2) & 1)) * 4)) * 4 + (cl & 3);
          pp[0] = w[0] * sc; pp[4] = w[NUP] * sc; pp[8] = w[2 * NUP] * sc; pp[12] = cbf * sc; } }
}

__device__ __forceinline__ void pool_diff(const _Float16* Y, float* stats, const float* g, bf16* Db, LAS float* st, int G, int tid, int wave, int lane) {
    for (int task = blockIdx.x; task < M / 32; task += G) {
        const int m0 = task * 32, t0 = m0 & (T - 1), nh = t0 < 15 ? t0 : 15;
        __syncthreads();
        for (int r0 = wave; r0 < 32 + nh; r0 += 3 * NWAVES) {
            h8 raw[3][8];
#pragma unroll
            for (int q = 0; q < 3; ++q) { const int r = r0 + q * NWAVES; if (r < 32 + nh) { const h8* yr = (const h8*)(Y + (size_t)(m0 - nh + r) * D) + lane;
#pragma unroll
                for (int j = 0; j < 8; ++j) raw[q][j] = yr[64 * j]; } }
#pragma unroll
            for (int q = 0; q < 3; ++q) { const int r = r0 + q * NWAVES; if (r < 32 + nh) { const int m = m0 - nh + r; f32x4 v[16]; float s = 0.f;
#pragma unroll
                for (int j = 0; j < 8; ++j) { const h8 y = raw[q][j]; v[2 * j] = (f32x4){(float)y[0], (float)y[1], (float)y[2], (float)y[3]}; v[2 * j + 1] = (f32x4){(float)y[4], (float)y[5], (float)y[6], (float)y[7]}; }
#pragma unroll
                for (int j = 0; j < 16; ++j) s += (v[j].x + v[j].y) + (v[j].z + v[j].w);
                const float mean = wave_sum(s) * (1.f / D); float s2 = 0.f;
#pragma unroll
                for (int j = 0; j < 16; ++j) { v[j] = v[j] - mean; s2 += (v[j].x * v[j].x + v[j].y * v[j].y) + (v[j].z * v[j].z + v[j].w * v[j].w); }
                const float rstd = 1.f / sqrtf(wave_sum(s2) * (1.f / D) + LN_EPS);
                if (lane == 0) { st[2 * r] = mean; st[2 * r + 1] = rstd; if (r >= nh) { stats[2 * m] = mean; stats[2 * m + 1] = rstd; } } } } }
        __syncthreads();
        const LAS float* sc = st + 2 * nh;
        for (int ch = 0; ch < 2; ++ch) { const int c = 4 * (ch * 512 + tid), w = 2 << (c >> 10);
            const f32x4 gg = *(const f32x4*)(g + c); const f32x4 zero = (f32x4){0.f, 0.f, 0.f, 0.f};
            auto ldb = [&](int rb, h4 (&re)[8], h4 (&rl)[8]) {
#pragma unroll
                for (int j = 0; j < 8; ++j) { const int r = rb * 8 + j; re[j] = *(const h4*)(Y + (size_t)(m0 + r) * D + c);
                    const bool ok = t0 + r - w + 1 >= 0; const int kl = ok ? r - w + 1 : r; rl[j] = *(const h4*)(Y + (size_t)(m0 + kl) * D + c); } };
            h4 reA[8], rlA[8], reB[8], rlB[8];
            ldb(0, reA, rlA);
            f32x4 sum = zero;
            { f32x4 pz[15];
#pragma unroll
              for (int i = 1; i < 16; ++i) { const bool ok = i < w && t0 - i >= 0; const int k = ok ? -i : 0; const float mu = sc[2 * k], rs = sc[2 * k + 1];
                  const f32x4 yv = ld4h(Y + (size_t)(m0 + k) * D + c);
                  pz[i - 1] = ok ? (yv - mu) * rs : zero; }
#pragma unroll
              for (int i = 0; i < 15; ++i) sum += pz[i]; }
            auto run = [&](int rb, const h4 (&re)[8], const h4 (&rl)[8]) {
#pragma unroll
                for (int j = 0; j < 8; ++j) { const int r = rb * 8 + j, t = t0 + r; const float mu = sc[2 * r], rs = sc[2 * r + 1];
                    const f32x4 ze = ((f32x4){(float)re[j][0], (float)re[j][1], (float)re[j][2], (float)re[j][3]} - mu) * rs;
                    const bool ok = t - w + 1 >= 0; const int kl = ok ? r - w + 1 : r; const float mu2 = sc[2 * kl], rs2 = sc[2 * kl + 1];
                    const f32x4 zl = ok ? ((f32x4){(float)rl[j][0], (float)rl[j][1], (float)rl[j][2], (float)rl[j][3]} - mu2) * rs2 : zero;
                    sum += ze;
                    const float icnt = __builtin_amdgcn_rcpf((float)(t + 1 < w ? t + 1 : w)); const f32x4 d = (sum * icnt - ze) * gg;
                    v2u o; o.x = cvtpk(d[0], d[1]); o.y = cvtpk(d[2], d[3]); *(v2u*)(Db + (size_t)(m0 + r) * D + c) = o;
                    sum -= zl; } };
            ldb(1, reB, rlB); run(0, reA, rlA);
            ldb(2, reA, rlA); run(1, reB, rlB);
            ldb(3, reB, rlB); run(2, reA, rlA);
            run(3, reB, rlB); }
    }
}

__device__ __forceinline__ void conv_fix(const float* halo, const float* cols, const float* cw, const float* cb, bf16* A2, int G, int tid) {
    constexpr int NF8 = DFF / 8, NTASK = (M / 256) * NF8;
    for (int id = blockIdx.x * 512 + tid; id < NTASK; id += G * 512) {
        const int pm = id / NF8, fi = id % NF8, f = fi * 8, Pc = (f >> 7) * 256 + (f & 127); const bool first = (pm & 7) == 0;
        float o0[8], o1[8];
#pragma unroll
        for (int hv = 0; hv < 2; ++hv)
#pragma unroll
            for (int q = 0; q < 2; ++q) { const int pc = Pc + hv * 128 + 4 * q, lc = hv * DFF + f + 4 * q;
                const f32x4 z = (f32x4){0.f, 0.f, 0.f, 0.f};
                const f32x4 bw = *(const f32x4*)(cols + NUP + pc);
                const f32x4 p2 = first ? z : *(const f32x4*)(halo + (size_t)((pm - 1) * 4 + 2) * NUP + pc) + bw, p3 = first ? z : *(const f32x4*)(halo + (size_t)((pm - 1) * 4 + 3) * NUP + pc) + bw;
                const f32x4 h0 = *(const f32x4*)(halo + (size_t)(pm * 4 + 0) * NUP + pc) + bw, h1 = *(const f32x4*)(halo + (size_t)(pm * 4 + 1) * NUP + pc) + bw;
                const f32x4 w0 = *(const f32x4*)(cw + lc), w1 = *(const f32x4*)(cw + NUP + lc), w2 = *(const f32x4*)(cw + 2 * NUP + lc), bb = *(const f32x4*)(cb + lc);
                const f32x4 r0 = ((bb + p2 * w0) + p3 * w1) + h0 * w2, r1 = ((bb + p3 * w0) + h0 * w1) + h1 * w2;
#pragma unroll
                for (int j = 0; j < 4; ++j) { if (hv == 0) { o0[4 * q + j] = r0[j] / (1.f + __expf(-r0[j])); o1[4 * q + j] = r1[j] / (1.f + __expf(-r1[j])); } else { o0[4 * q + j] *= r0[j]; o1[4 * q + j] *= r1[j]; } } }
        v4u a, b; a.x = cvtpk(o0[0], o0[1]); a.y = cvtpk(o0[2], o0[3]); a.z = cvtpk(o0[4], o0[5]); a.w = cvtpk(o0[6], o0[7]); b.x = cvtpk(o1[0], o1[1]); b.y = cvtpk(o1[2], o1[3]); b.z = cvtpk(o1[4], o1[5]); b.w = cvtpk(o1[6], o1[7]);
        *(v4u*)(A2 + (size_t)(pm * 256) * DFF + f) = a; *(v4u*)(A2 + (size_t)(pm * 256 + 1) * DFF + f) = b;
    }
}

__device__ __forceinline__ void compress_phase(const Ptrs& P, LAS unsigned char* lds, int gw, int NGW, int wave, int lane) {
    unsigned char* ws = P.ws; const bf16* HQ = (const bf16*)(ws + WS_HQ);
    const float* ct = (const float*)(ws + WS_COS); const float* st = (const float*)(ws + WS_SIN);
    const int r32 = lane & 31, hi = lane >> 5;
    LAS float* xb = (LAS float*)(lds + RING_OFF) + (wave >> 1) * 1024;
    for (int task2 = gw; task2 < 2 * 64 * 16; task2 += NGW) {
        const int task = task2 >> 1, kh = task2 & 1;
        const int combo = task >> 4, nb = (task >> 2) & 3, eb = task & 3, kv = combo & 1, h = (combo >> 1) & 3, b = combo >> 3;
        const int p = eb * 32 + r32;
        const int e = kv ? p : (64 * ((p >> 2) & 1) + 4 * (p >> 3) + (p & 3));
        int n = nb * 32 + r32; if (n > 126) n = 126;
        const bf16* arow = HQ + ((size_t)((kv ? C_VC : C_KC) / HD + h) * M + b * T + 16 * n + 16 * kh) * HD + hi * 8;
        const bf16* brow = (const bf16*)(ws + (kv ? WS_WCVT : WS_WCKT)) + (size_t)e * 4096 + kh * 2048 + hi * 8;
        f32x16 acc = {};
#pragma unroll 16
        for (int s = 0; s < 128; ++s) { const int l = s >> 3, d0 = (s & 7) * 16;
            const bf16x8 a = *(const bf16x8*)(arow + l * HD + d0), bb = *(const bf16x8*)(brow + s * 16);
            acc = __builtin_amdgcn_mfma_f32_32x32x16_bf16(a, bb, acc, 0, 0, 0); }
        __syncthreads();
        if (kh) {
#pragma unroll
            for (int r = 0; r < 16; ++r) xb[r * 64 + lane] = acc[r]; }
        __syncthreads();
        if (!kh) {
            const float cst = ((const float*)(ws + (kv ? WS_CV : WS_CK)))[e];
            bf16* outp = (bf16*)(ws + (kv ? WS_VC : WS_KC)) + (size_t)((b * 4 + h) * 128) * 128 + p;
#pragma unroll
            for (int r = 0; r < 16; ++r) { const int nr = nb * 32 + (r & 3) + 8 * (r >> 2) + 4 * hi; float v = (acc[r] + xb[r * 64 + lane]) + cst;
                if (!kv) { const float pv = __shfl_xor(v, 4); int pos = 16 * nr + 31; if (pos > T - 1) pos = T - 1; const int i = 4 * (p >> 3) + (p & 3); const float c = ct[pos * 64 + i], s = st[pos * 64 + i];
                    v = ((p >> 2) & 1) ? (pv * s + v * c) : (v * c - pv * s); }
                outp[(size_t)nr * 128] = (bf16)(cvtpk(v, v) & 0xffffu); } }
    }
}

namespace at {
constexpr float SCALE = 0.088388347648318440f, CS = SCALE * 1.4426950408889634f;
constexpr float NEGM = -2.0e30f, MINIT = -1.0e30f;
constexpr int ATT_K = 0, ATT_V = 32768, ATT_K2 = 65536, ATT_V2 = 81920, ATT_IMP = 65536, ATT_WS = 98304, ATT_FLAG = ATT_WS + 2048, ATT_SELM = ATT_FLAG + 256;
#define KSWZ(row, colB) ((row) * 256 + ((colB) ^ (((row) & 7) << 4)))
#define SBAR() __builtin_amdgcn_sched_barrier(0)
__device__ __forceinline__ int crow(int r, int hi) { return (r & 3) + 8 * (r >> 2) + 4 * hi; }
__device__ __forceinline__ int v_st(int k, int c) { const int kk = (k & ~0xC) | ((k & 4) << 1) | ((k & 8) >> 1); return ((kk >> 3) * 4 + (c >> 5)) * 512 + ((kk & 7) * 32 + (c & 31)) * 2; }
__device__ __forceinline__ int v_rd_base(int lane) { return ((lane & 3) << 3) | (((lane >> 2) & 3) << 6) | (((lane >> 4) & 1) << 5) | (((lane >> 5) & 1) << 8); }
constexpr int v_rd_off(int d0, int ks, int half) { return d0 * 512 + ks * 4096 + half * 2048; }
template <int OFF> __device__ __forceinline__ s16x4 tr_read(int vb) { s16x4 r; asm volatile("ds_read_b64_tr_b16 %0, %1 offset:%2" : "=&v"(r) : "v"(vb), "i"(OFF) : "memory"); return r; }
struct VF { s16x4 l0, h0, l1, h1, l2, h2, l3, h3; };
template <int KS> __device__ __forceinline__ VF pv_read(int vb) { VF f;
    f.l0 = tr_read<v_rd_off(0, KS, 0)>(vb); f.h0 = tr_read<v_rd_off(0, KS, 1)>(vb); f.l1 = tr_read<v_rd_off(1, KS, 0)>(vb); f.h1 = tr_read<v_rd_off(1, KS, 1)>(vb);
    f.l2 = tr_read<v_rd_off(2, KS, 0)>(vb); f.h2 = tr_read<v_rd_off(2, KS, 1)>(vb); f.l3 = tr_read<v_rd_off(3, KS, 0)>(vb); f.h3 = tr_read<v_rd_off(3, KS, 1)>(vb); return f; }
__device__ __forceinline__ void pv_mma(f32x16 (&o)[4], bf16x8 pa, const VF& f) {
#define PK(L, H) (bf16x8){L[0], L[1], L[2], L[3], H[0], H[1], H[2], H[3]}
    o[0] = __builtin_amdgcn_mfma_f32_32x32x16_bf16(pa, PK(f.l0, f.h0), o[0], 0, 0, 0);
    o[1] = __builtin_amdgcn_mfma_f32_32x32x16_bf16(pa, PK(f.l1, f.h1), o[1], 0, 0, 0);
    o[2] = __builtin_amdgcn_mfma_f32_32x32x16_bf16(pa, PK(f.l2, f.h2), o[2], 0, 0, 0);
    o[3] = __builtin_amdgcn_mfma_f32_32x32x16_bf16(pa, PK(f.l3, f.h3), o[3], 0, 0, 0);
#undef PK
}
__device__ __forceinline__ void pv_d0(f32x16 (&o)[4], int vb, bf16x8 pa0, bf16x8 pa1, bf16x8 pa2, bf16x8 pa3) {
    const VF f0 = pv_read<0>(vb); const VF f1 = pv_read<1>(vb);
    asm volatile("s_waitcnt lgkmcnt(8)" ::: "memory"); SBAR(); pv_mma(o, pa0, f0);
    const VF f2 = pv_read<2>(vb);
    asm volatile("s_waitcnt lgkmcnt(8)" ::: "memory"); SBAR(); pv_mma(o, pa1, f1);
    const VF f3 = pv_read<3>(vb);
    asm volatile("s_waitcnt lgkmcnt(8)" ::: "memory"); SBAR(); pv_mma(o, pa2, f2);
    asm volatile("s_waitcnt lgkmcnt(0)" ::: "memory"); SBAR(); pv_mma(o, pa3, f3);
}
__device__ __forceinline__ void k_rd(bf16x8& a, bf16x8& b, unsigned addr) {
    asm volatile("ds_read_b128 %0, %2\n\tds_read_b128 %1, %2 offset:8192" : "=&v"(a), "=&v"(b) : "v"(addr) : "memory"); }
#define K_WAIT(n, a, b) asm volatile("s_waitcnt lgkmcnt(" #n ")" : "+v"(a), "+v"(b) :: "memory")
__device__ __forceinline__ void qkt(f32x16& p0, f32x16& p1, const LAS unsigned char* Ks, const bf16x8 (&qr)[8], int r32, int hi) {
    const unsigned base = (unsigned)(uintptr_t)Ks + (unsigned)(r32 * 256), sw = (unsigned)((r32 & 7) << 4), h16 = (unsigned)(hi * 16);
#define K_ADDR(d0) (base + (((unsigned)((d0) * 32) + h16) ^ sw))
    bf16x8 a0, b0, a1, b1, a2, b2;
    k_rd(a0, b0, K_ADDR(0)); k_rd(a1, b1, K_ADDR(1)); k_rd(a2, b2, K_ADDR(2));
    p0 = f32x16{}; p1 = f32x16{};
    K_WAIT(4, a0, b0); p0 = __builtin_amdgcn_mfma_f32_32x32x16_bf16(a0, qr[0], p0, 0, 0, 0); p1 = __builtin_amdgcn_mfma_f32_32x32x16_bf16(b0, qr[0], p1, 0, 0, 0); k_rd(a0, b0, K_ADDR(3));
    K_WAIT(4, a1, b1); p0 = __builtin_amdgcn_mfma_f32_32x32x16_bf16(a1, qr[1], p0, 0, 0, 0); p1 = __builtin_amdgcn_mfma_f32_32x32x16_bf16(b1, qr[1], p1, 0, 0, 0); k_rd(a1, b1, K_ADDR(4));
    K_WAIT(4, a2, b2); p0 = __builtin_amdgcn_mfma_f32_32x32x16_bf16(a2, qr[2], p0, 0, 0, 0); p1 = __builtin_amdgcn_mfma_f32_32x32x16_bf16(b2, qr[2], p1, 0, 0, 0); k_rd(a2, b2, K_ADDR(5));
    K_WAIT(4, a0, b0); p0 = __builtin_amdgcn_mfma_f32_32x32x16_bf16(a0, qr[3], p0, 0, 0, 0); p1 = __builtin_amdgcn_mfma_f32_32x32x16_bf16(b0, qr[3], p1, 0, 0, 0); k_rd(a0, b0, K_ADDR(6));
    K_WAIT(4, a1, b1); p0 = __builtin_amdgcn_mfma_f32_32x32x16_bf16(a1, qr[4], p0, 0, 0, 0); p1 = __builtin_amdgcn_mfma_f32_32x32x16_bf16(b1, qr[4], p1, 0, 0, 0); k_rd(a1, b1, K_ADDR(7));
    K_WAIT(4, a2, b2); p0 = __builtin_amdgcn_mfma_f32_32x32x16_bf16(a2, qr[5], p0, 0, 0, 0); p1 = __builtin_amdgcn_mfma_f32_32x32x16_bf16(b2, qr[5], p1, 0, 0, 0);
    K_WAIT(2, a0, b0); p0 = __builtin_amdgcn_mfma_f32_32x32x16_bf16(a0, qr[6], p0, 0, 0, 0); p1 = __builtin_amdgcn_mfma_f32_32x32x16_bf16(b0, qr[6], p1, 0, 0, 0);
    K_WAIT(0, a1, b1); p0 = __builtin_amdgcn_mfma_f32_32x32x16_bf16(a1, qr[7], p0, 0, 0, 0); p1 = __builtin_amdgcn_mfma_f32_32x32x16_bf16(b1, qr[7], p1, 0, 0, 0);
#undef K_ADDR
}
#undef K_WAIT
__device__ __forceinline__ float pair_max(float x) { auto rr = __builtin_amdgcn_permlane32_swap(__float_as_uint(x), __float_as_uint(x), false, false); return fmaxf(__uint_as_float(rr[0]), __uint_as_float(rr[1])); }
__device__ __forceinline__ float pair_sum(float x) { auto rr = __builtin_amdgcn_permlane32_swap(__float_as_uint(x), __float_as_uint(x), false, false); return __uint_as_float(rr[0]) + __uint_as_float(rr[1]); }
__device__ __forceinline__ float pair_other(float x, int hi) { auto rr = __builtin_amdgcn_permlane32_swap(__float_as_uint(x), __float_as_uint(x), false, false); return __uint_as_float(hi ? rr[0] : rr[1]); }
__device__ __forceinline__ void p_to_frags(const f32x16& p0, const f32x16& p1, bf16x8& pa0, bf16x8& pa1, bf16x8& pa2, bf16x8& pa3) {
#define PK4(P, BASE, OUT) do { unsigned a0 = cvtpk(P[BASE + 0], P[BASE + 1]), a1 = cvtpk(P[BASE + 2], P[BASE + 3]);   \
    unsigned b0 = cvtpk(P[BASE + 4], P[BASE + 5]), b1 = cvtpk(P[BASE + 6], P[BASE + 7]);                              \
    auto r0 = __builtin_amdgcn_permlane32_swap(a0, b0, false, false); auto r1 = __builtin_amdgcn_permlane32_swap(a1, b1, false, false); \
    v4u w = {r0[0], r1[0], r0[1], r1[1]}; OUT = *reinterpret_cast<bf16x8*>(&w); } while (0)
    PK4(p0, 0, pa0); PK4(p0, 8, pa1); PK4(p1, 0, pa2); PK4(p1, 8, pa3);
#undef PK4
}
constexpr float THR_RAW = 8.f / SCALE;
__device__ __forceinline__ float softmax_tile(f32x16& p0, f32x16& p1, float& m_reg, float& l_reg, f32x16 (&o)[4], LAS float* al_l, int r32, int hi, bool lane_on = true) {
    float pmax = fmaxf(fmaxf(p0[0], p0[1]), p0[2]);
#pragma unroll
    for (int r = 3; r < 15; r += 2) pmax = fmaxf(fmaxf(pmax, p0[r]), p0[r + 1]);
    pmax = fmaxf(fmaxf(pmax, p0[15]), p1[0]);
#pragma unroll
    for (int r = 1; r < 15; r += 2) pmax = fmaxf(fmaxf(pmax, p1[r]), p1[r + 1]);
    pmax = fmaxf(pmax, p1[15]);
    pmax = pair_max(pmax); pmax = lane_on ? pmax : NEGM;
    float mn = m_reg, alpha = 1.f;
    if (!__all(pmax - m_reg <= THR_RAW)) { mn = fmaxf(m_reg, pmax); alpha = __builtin_amdgcn_exp2f((m_reg - mn) * CS); m_reg = mn;
        if (hi == 0) al_l[r32] = alpha; LDS_WAIT();
#pragma unroll
        for (int d = 0; d < 4; ++d)
#pragma unroll
            for (int r = 0; r < 16; ++r) o[d][r] *= al_l[crow(r, hi)];
        LDS_WAIT(); }
    const float mnC = lane_on ? -mn * CS : -__builtin_inff();
#pragma unroll
    for (int r = 0; r < 16; ++r) { p0[r] = __builtin_amdgcn_exp2f(fmaf(p0[r], CS, mnC)); p1[r] = __builtin_amdgcn_exp2f(fmaf(p1[r], CS, mnC)); }
    float ps = 0.f;
#pragma unroll
    for (int r = 0; r < 16; ++r) ps += p0[r] + p1[r];
    ps = pair_sum(ps);
    l_reg = l_reg * alpha + ps;
    return alpha;
}
struct Stage { bf16x8 k0, k1, v0, v1; };
__device__ __forceinline__ void kv_load(Stage& s, const bf16* Kg, const bf16* Vg, int ld, int row0, int sr, int sc) {
    const unsigned o0 = (unsigned)((row0 + sr) * ld + sc), o1 = o0 + (unsigned)(32 * ld);
    s.k0 = *(const bf16x8*)(Kg + o0); s.k1 = *(const bf16x8*)(Kg + o1); s.v0 = *(const bf16x8*)(Vg + o0); s.v1 = *(const bf16x8*)(Vg + o1);
}
__device__ __forceinline__ void kv_write(const Stage& s, LAS unsigned char* Kb, LAS unsigned char* Vb, int sr, int sc) {
    *(LAS bf16x8*)(Vb + v_st(sr, sc)) = s.v0; *(LAS bf16x8*)(Vb + v_st(32 + sr, sc)) = s.v1;
    *(LAS bf16x8*)(Kb + KSWZ(sr, sc * 2)) = s.k0; *(LAS bf16x8*)(Kb + KSWZ(32 + sr, sc * 2)) = s.k1;
}
template <bool EARLY, class Body>
__device__ __forceinline__ void kv_tile_loop(const bf16* Kg, const bf16* Vg, int ld, int t_first, int n_tiles, int step, LAS unsigned char* lds, int tid, int lane, Body&& body) {
    int tid_o = tid; asm volatile("" : "+v"(tid_o));
    const int sr = tid_o >> 4, sc = (tid_o & 15) * 8;
    Stage st; kv_load(st, Kg, Vg, ld, 64 * t_first, sr, sc);
    __syncthreads();
    kv_write(st, lds + ATT_K, lds + ATT_V, sr, sc);
    __syncthreads();
    for (int i = 0; i < n_tiles; ++i) { const int tile = t_first + i * step, b = i & 1;
        if (i + 1 < n_tiles) kv_load(st, Kg, Vg, ld, 64 * (tile + step), sr, sc);
        body(tile, i, (const LAS unsigned char*)(lds + ATT_K + b * 16384), (int)(unsigned)(uintptr_t)(lds + ATT_V + b * 16384) + v_rd_base(lane));
        if (i + 1 < n_tiles) kv_write(st, lds + ATT_K + (b ^ 1) * 16384, lds + ATT_V + (b ^ 1) * 16384, sr, sc);
        __syncthreads();
        if (EARLY) { const LAS unsigned* fl = (const LAS unsigned*)(lds + ATT_FLAG) + 8 * b; unsigned a = 1u;
#pragma unroll
            for (int w = 0; w < 8; ++w) a &= fl[w];
            if (a) break; }
    }
}
template <class QK, class SM, class PV>
__device__ __forceinline__ void kv_tile_loop_skew(const bf16* Kg, const bf16* Vg, int ld, int t_first, int n_tiles, LAS unsigned char* lds, int tid, int lane, bool late, QK&& qk, SM&& sm, PV&& pv) {
    asm volatile("" : "+v"(lane));
    const int wv = __builtin_amdgcn_readfirstlane(tid >> 6), vlane = v_rd_base(lane);
    unsigned offK, offV;
    { const int row = 4 * wv + (lane >> 4), cb = ((lane & 15) * 16) ^ ((row & 7) << 4); offK = (unsigned)(row * ld + cb / 2);
      const int sidx = 2 * wv + (lane >> 5), kk = (sidx >> 2) * 8 + ((lane & 31) >> 2), k = (kk & ~0xC) | ((kk & 4) << 1) | ((kk & 8) >> 1), c = (sidx & 3) * 32 + (lane & 3) * 8; offV = (unsigned)(k * ld + c); }
#define KBUF(i) ((i) < 2 ? ATT_K + (i) * 16384 : ATT_K2)
#define VBUF(i) ((i) < 2 ? ATT_V + (i) * 16384 : ATT_V2)
#define DMA_TILE(tile, b) do { const bf16* kt_ = Kg + (size_t)(64 * (tile)) * ld; const bf16* vt_ = Vg + (size_t)(64 * (tile)) * ld;                                                   \
        __builtin_amdgcn_global_load_lds((const unsigned*)(kt_ + offK), (LAS unsigned*)(lds + KBUF(b) + wv * 1024), 16, 0, 0);                                                       \
        __builtin_amdgcn_global_load_lds((const unsigned*)(kt_ + offK + (unsigned)(32 * ld)), (LAS unsigned*)(lds + KBUF(b) + (wv + 8) * 1024), 16, 0, 0);                         \
        __builtin_amdgcn_global_load_lds((const unsigned*)(vt_ + offV), (LAS unsigned*)(lds + VBUF(b) + wv * 1024), 16, 0, 0);                                                       \
        __builtin_amdgcn_global_load_lds((const unsigned*)(vt_ + offV + (unsigned)(32 * ld)), (LAS unsigned*)(lds + VBUF(b) + (wv + 8) * 1024), 16, 0, 0); } while (0)
#define WG_BAR() do { asm volatile("s_waitcnt lgkmcnt(0)" ::: "memory"); __builtin_amdgcn_s_barrier(); asm volatile("" ::: "memory"); } while (0)
    __syncthreads();
    DMA_TILE(t_first, 0);
    if (n_tiles > 1) { DMA_TILE(t_first + 1, 1); asm volatile("s_waitcnt vmcnt(4)" ::: "memory"); } else asm volatile("s_waitcnt vmcnt(0)" ::: "memory");
    WG_BAR();
    int b = 0;
    for (int i = 0; i < n_tiles; ++i) { const int tile = t_first + i, b2 = b == 0 ? 2 : b - 1, b1 = b == 2 ? 0 : b + 1;
        if (i + 2 < n_tiles) DMA_TILE(tile + 2, b2);
        qk((const LAS unsigned char*)(lds + KBUF(b))); sm(tile); pv((int)(unsigned)(uintptr_t)(lds + VBUF(b)) + vlane);
        if (i + 1 < n_tiles) { if (i + 2 < n_tiles) asm volatile("s_waitcnt vmcnt(4)" ::: "memory"); else asm volatile("s_waitcnt vmcnt(0)" ::: "memory"); }
        WG_BAR();
        b = b1; }
#undef KBUF
#undef VBUF
#undef DMA_TILE
#undef WG_BAR
    (void)late;
}
constexpr ptrdiff_t OACC1_OFF = 64 * 512;
template <int MODE>
__device__ __forceinline__ void scale_store(const f32x16 (&o)[4], float f, LAS float* li_l, int r32, int hi, float* oacc_row0, bf16* oc_row0, int ldacc, int ldoc) {
    if (hi == 0) li_l[r32] = f; LDS_WAIT();
    float rf[16];
#pragma unroll
    for (int r = 0; r < 16; ++r) rf[r] = li_l[crow(r, hi)];
    LDS_WAIT();
    int orow = 4 * hi;
#pragma unroll
    for (int rb = 0; rb < 4; ++rb) { asm volatile("" : "+v"(orow));
        float a0[4][4], a1[4][4];
        if (MODE == 2) {
#pragma unroll
            for (int j = 0; j < 4; ++j)
#pragma unroll
                for (int d0 = 0; d0 < 4; ++d0) { const unsigned ia = (unsigned)((orow + j) * ldacc + d0 * 32 + r32); a0[j][d0] = oacc_row0[ia]; a1[j][d0] = (oacc_row0 + OACC1_OFF)[ia]; } }
#pragma unroll
        for (int j = 0; j < 4; ++j)
#pragma unroll
            for (int d0 = 0; d0 < 4; ++d0) { float v = o[d0][4 * rb + j] * rf[4 * rb + j]; const unsigned ia = (unsigned)((orow + j) * ldacc + d0 * 32 + r32), ic = (unsigned)((orow + j) * ldoc + d0 * 32 + r32);
                if (MODE == 0) oacc_row0[ia] = v;
                if (MODE == 1) (oacc_row0 + OACC1_OFF)[ia] = v;
                if (MODE == 2) v += a0[j][d0] + a1[j][d0];
                if (MODE >= 2) oc_row0[ic] = (bf16)(cvtpk(v, v) & 0xffffu); }
        orow += 8;
        asm volatile("" ::: "memory"); }
}
__device__ __forceinline__ float sigmoidf_(float x) { return 1.f / (1.f + __expf(-x)); }


__device__ __forceinline__ void nsa_unit(const Ptrs& P, LAS unsigned char* lds, int combo, int qt, int tid, int wave, int lane) {
    unsigned char* ws = P.ws; const bf16* HQ = (const bf16*)(ws + WS_HQ);
    const int r32 = lane & 31, hi = lane >> 5, g = wave & 3, qh = wave >> 2;
    const int b = combo >> 2, kvh = combo & 3, head = kvh * 4 + g;
    const int tq = 64 * qt + 32 * qh + r32;
    const size_t mrow0 = (size_t)b * T + 64 * qt + 32 * qh;
    LAS float* wsl = (LAS float*)(lds + ATT_WS) + wave * 64; LAS float* li_l = wsl; LAS float* al_l = wsl + 32;
    bf16x8 qr[8];
    { const bf16* Qw = HQ + ((size_t)(C_QA / HD + head) * M + mrow0) * HD; const unsigned qo = (unsigned)(r32 * HD + hi * 8);
#pragma unroll
      for (int d0 = 0; d0 < 8; ++d0) qr[d0] = *(const bf16x8*)(Qw + (qo + d0 * 16)); }
    float* oacc_row0 = (float*)(ws + WS_OACC) + (size_t)blockIdx.x * (2 * 64 * 512) + (32 * qh) * 512 + g * HD; bf16* oc_row0 = (bf16*)(ws + WS_OC) + mrow0 * D + head * HD;
    const bf16* grow = HQ + ((size_t)(C_GATE / HD) * M + mrow0) * HD + head; const unsigned go = (unsigned)(r32 * HD);
    f32x16 o[4]; float m_reg, l_reg;
    {
        float gs[16], e3[16];
#pragma unroll
        for (int a = 0; a < 16; ++a) { gs[a] = 0.f; e3[a] = 0.f; }
        int tid_o = tid; asm volatile("" : "+v"(tid_o));
        const int ntc = (4 * qt + 2) / 64 + 1, sr = tid_o >> 4, sc = (tid_o & 15) * 8;
        const bf16* Kg = (const bf16*)(ws + WS_KC) + (size_t)combo * 128 * 128; const bf16* Vg = (const bf16*)(ws + WS_VC) + (size_t)combo * 128 * 128;
        Stage st; kv_load(st, Kg, Vg, 128, 0, sr, sc);
        __syncthreads();
        kv_write(st, lds + ATT_K, lds + ATT_V, sr, sc);
        if (ntc == 2) { kv_load(st, Kg, Vg, 128, 64, sr, sc); kv_write(st, lds + ATT_K + 16384, lds + ATT_V + 16384, sr, sc); }
        __syncthreads();
#pragma unroll
        for (int d = 0; d < 4; ++d) o[d] = f32x16{};
        m_reg = MINIT; l_reg = 0.f;
#define CMP_TILE(TI) do { f32x16 p0, p1; qkt(p0, p1, (const LAS unsigned char*)(lds + ATT_K + (TI) * 16384), qr, r32, hi);                                   \
        { const int nlim = ((tq - 31) >> 4) - 4 * hi - 64 * (TI);              \
        _Pragma("unroll") for (int r = 0; r < 16; ++r) { const int kr = (r & 3) + 8 * (r >> 2);                                                              \
            p0[r] = (kr <= nlim) ? p0[r] : NEGM; p1[r] = (kr + 32 <= nlim) ? p1[r] : NEGM; } }                                                                \
        const float alpha = softmax_tile(p0, p1, m_reg, l_reg, o, al_l, r32, hi);                                                                             \
        if ((TI) == 1) { _Pragma("unroll") for (int a = 0; a < 8; ++a) { gs[a] *= alpha; e3[a] *= alpha; } }                                                  \
        _Pragma("unroll") for (int a = 0; a < 4; ++a) { gs[8 * (TI) + a] = (p0[4 * a] + p0[4 * a + 1]) + (p0[4 * a + 2] + 0.5f * p0[4 * a + 3]); e3[8 * (TI) + a] = 0.5f * p0[4 * a + 3];   \
            gs[8 * (TI) + 4 + a] = (p1[4 * a] + p1[4 * a + 1]) + (p1[4 * a + 2] + 0.5f * p1[4 * a + 3]); e3[8 * (TI) + 4 + a] = 0.5f * p1[4 * a + 3]; }     \
        bf16x8 pa0, pa1, pa2, pa3; p_to_frags(p0, p1, pa0, pa1, pa2, pa3);                                                                                   \
        pv_d0(o, (int)(unsigned)(uintptr_t)(lds + ATT_V + (TI) * 16384) + v_rd_base(lane), pa0, pa1, pa2, pa3); } while (0)
        CMP_TILE(0);
        if (ntc == 2) CMP_TILE(1);
#undef CMP_TILE
        const float inv = l_reg > 0.f ? 1.f / l_reg : 0.f;
        LAS float* imp = (LAS float*)(lds + ATT_IMP) + (g * 64 + qh * 32 + r32) * 32;
        float oprev = 0.f;
#pragma unroll
        for (int a = 0; a < 16; ++a) { const float oth = pair_other(e3[a], hi);
            imp[2 * a + hi] = (gs[a] + (hi ? oth : oprev)) * inv; oprev = oth; }
        const float gate = sigmoidf_(bf2f(grow[go]));
        scale_store<0>(o, gate * inv, li_l, r32, hi, oacc_row0, oc_row0, 512, D);
    }
    __syncthreads();
    {
        const int q = tid >> 3, sub = tid & 7; const LAS float* ip = (const LAS float*)(lds + ATT_IMP) + q * 32;
        float vv[32];
#pragma unroll
        for (int j = 0; j < 32; ++j) { const float v = ((ip[j] + ip[2048 + j]) + ip[4096 + j]) + ip[6144 + j];
            vv[j] = ((j == 0) | (j == qt) | (j == qt - 1)) ? 1e9f : (j <= qt ? v : -1e30f); }
        unsigned bits = 0u;
#pragma unroll
        for (int jj = 0; jj < 4; ++jj) { const int j = 4 * sub + jj; const float v = ((ip[j] + ip[2048 + j]) + ip[4096 + j]) + ip[6144 + j];
            const float mv = ((j == 0) | (j == qt) | (j == qt - 1)) ? 1e9f : (j <= qt ? v : -1e30f); int cnt = 0;
#pragma unroll
            for (int i = 0; i < 32; ++i) cnt += ((vv[i] > mv) | ((vv[i] == mv) & (i < j))) ? 1 : 0;
            if (cnt < 16 && j <= qt) bits |= 1u << j; }
        bits |= __shfl_xor(bits, 1); bits |= __shfl_xor(bits, 2); bits |= __shfl_xor(bits, 4);
        if (sub == 0) ((LAS unsigned*)(lds + ATT_SELM))[q] = bits;
    }
    __syncthreads();
    const unsigned selmask = ((const LAS unsigned*)(lds + ATT_SELM))[qh * 32 + r32];
    {
#pragma unroll
        for (int d = 0; d < 4; ++d) o[d] = f32x16{};
        m_reg = MINIT; l_reg = 0.f;
        const bf16* Kg = HQ + ((size_t)(C_KS / HD + kvh) * M + (size_t)b * T) * HD; const bf16* Vg = HQ + ((size_t)(C_VS / HD + kvh) * M + (size_t)b * T) * HD;
        f32x16 p0, p1; bf16x8 pa0, pa1, pa2, pa3;
        kv_tile_loop_skew(Kg, Vg, HD, 0, qt + 1, lds, tid, lane, qh != 0,
            [&](const LAS unsigned char* Ks) { qkt(p0, p1, Ks, qr, r32, hi); },
            [&](int tile) { const bool on = (selmask >> tile) & 1u;
                if (tile == qt) { const int lim = tq - 64 * tile - 4 * hi;
#pragma unroll
                    for (int r = 0; r < 16; ++r) { const int kr = (r & 3) + 8 * (r >> 2); p0[r] = (kr <= lim) ? p0[r] : NEGM; p1[r] = (kr + 32 <= lim) ? p1[r] : NEGM; } }
                softmax_tile(p0, p1, m_reg, l_reg, o, al_l, r32, hi, on); p_to_frags(p0, p1, pa0, pa1, pa2, pa3); },
            [&](int vb) { pv_d0(o, vb, pa0, pa1, pa2, pa3);
#if defined(MK_XPV)
                { f32x16 od[4]; od[0] = f32x16{}; od[1] = f32x16{}; od[2] = f32x16{}; od[3] = f32x16{}; asm volatile("" ::: "memory"); pv_d0(od, vb, pa0, pa1, pa2, pa3); asm volatile("" :: "v"(od[0]), "v"(od[1]), "v"(od[2]), "v"(od[3])); }
#endif
            });
        const float inv = l_reg > 0.f ? 1.f / l_reg : 0.f;
        const float gate = sigmoidf_(bf2f(grow[go + 16]));
        scale_store<1>(o, gate * inv, li_l, r32, hi, oacc_row0, oc_row0, 512, D);
    }
    {
#pragma unroll
        for (int d = 0; d < 4; ++d) o[d] = f32x16{};
        m_reg = MINIT; l_reg = 0.f;
        const bf16* Kg = HQ + ((size_t)(C_KW / HD + kvh) * M + (size_t)b * T) * HD; const bf16* Vg = HQ + ((size_t)(C_VW / HD + kvh) * M + (size_t)b * T) * HD;
        const int t_lo = qt - 8 > 0 ? qt - 8 : 0;
        f32x16 p0, p1; bf16x8 pa0, pa1, pa2, pa3;
        kv_tile_loop_skew(Kg, Vg, HD, t_lo, qt - t_lo + 1, lds, tid, lane, qh != 0,
            [&](const LAS unsigned char* Ks) { qkt(p0, p1, Ks, qr, r32, hi); },
            [&](int tile) {
                if (tile == qt || tile == qt - 8) { const int lim = tq - 64 * tile - 4 * hi;
#pragma unroll
                    for (int r = 0; r < 16; ++r) { const int kr = (r & 3) + 8 * (r >> 2); p0[r] = (kr <= lim && kr > lim - 512) ? p0[r] : NEGM; p1[r] = (kr + 32 <= lim && kr + 32 > lim - 512) ? p1[r] : NEGM; } }
                softmax_tile(p0, p1, m_reg, l_reg, o, al_l, r32, hi); p_to_frags(p0, p1, pa0, pa1, pa2, pa3); },
            [&](int vb) { pv_d0(o, vb, pa0, pa1, pa2, pa3);
#if defined(MK_XPV)
                { f32x16 od[4]; od[0] = f32x16{}; od[1] = f32x16{}; od[2] = f32x16{}; od[3] = f32x16{}; asm volatile("" ::: "memory"); pv_d0(od, vb, pa0, pa1, pa2, pa3); asm volatile("" :: "v"(od[0]), "v"(od[1]), "v"(od[2]), "v"(od[3])); }
#endif
            });
        const float inv = l_reg > 0.f ? 1.f / l_reg : 0.f;
        const float gate = sigmoidf_(bf2f(grow[go + 32]));
        scale_store<2>(o, gate * inv, li_l, r32, hi, oacc_row0, oc_row0, 512, D);
    }
}

__device__ __forceinline__ void sb_unit(const Ptrs& P, LAS unsigned char* lds, int combo, int qt, int tid, int wave, int lane) {
    unsigned char* ws = P.ws; const bf16* HQ = (const bf16*)(ws + WS_HQ);
    const int r32 = lane & 31, hi = lane >> 5;
    const int b = combo >> 4, h = combo & 15;
    const int tq0 = 256 * qt + 32 * wave, tq = tq0 + r32;
    const size_t mrow0 = (size_t)b * T + tq0;
    LAS float* li_l = (LAS float*)(lds + ATT_WS) + wave * 64;
    bf16x8 qr[8];
    { const bf16* Qw = HQ + ((size_t)(C_QB / HD + h) * M + mrow0) * HD; const unsigned qo = (unsigned)(r32 * HD + hi * 8);
#pragma unroll
      for (int d0 = 0; d0 < 8; ++d0) qr[d0] = *(const bf16x8*)(Qw + (qo + d0 * 16)); }
    f32x16 o[4];
#pragma unroll
    for (int d = 0; d < 4; ++d) o[d] = f32x16{};
    float R = 0.f; bool done = false;
    const bf16* Kg = HQ + ((size_t)(C_KB / HD + h) * M + (size_t)b * T) * HD; const bf16* Vg = HQ + ((size_t)(C_VB / HD + h) * M + (size_t)b * T) * HD;
    const int tile_hi = 4 * qt + 3;
    kv_tile_loop<true>(Kg, Vg, HD, tile_hi, tile_hi + 1, -1, lds, tid, lane, [&](int tile, int it, const LAS unsigned char* Ks, int vb) {
        if (64 * tile <= tq0 + 30 && !done) {
            f32x16 p0, p1, s0, s1; qkt(p0, p1, Ks, qr, r32, hi);
            const int lim = tq - 64 * tile - 4 * hi;
#pragma unroll
            for (int r = 0; r < 16; ++r) { const int kr = (r & 3) + 8 * (r >> 2);
                { const float z = p0[r] * CS, sp = fmaxf(z, 0.f) + __builtin_amdgcn_logf(1.f + __builtin_amdgcn_exp2f(-fabsf(z))); const bool v = kr < lim; s0[r] = v ? sp : 0.f; p0[r] = v ? z - sp : MINIT; }
                { const float z = p1[r] * CS, sp = fmaxf(z, 0.f) + __builtin_amdgcn_logf(1.f + __builtin_amdgcn_exp2f(-fabsf(z))); const bool v = kr + 32 < lim; s1[r] = v ? sp : 0.f; p1[r] = v ? z - sp : MINIT; } }
            float gsum[8], pg[8];
#pragma unroll
            for (int a = 0; a < 4; ++a) { gsum[a] = (s0[4 * a] + s0[4 * a + 1]) + (s0[4 * a + 2] + s0[4 * a + 3]); gsum[4 + a] = (s1[4 * a] + s1[4 * a + 1]) + (s1[4 * a + 2] + s1[4 * a + 3]); }
#pragma unroll
            for (int a = 0; a < 8; ++a) pg[a] = pair_other(gsum[a], hi);
            float suf = 0.f;
#pragma unroll
            for (int a = 3; a >= 0; --a) { const float base = R + suf + (hi ? 0.f : pg[4 + a]);
                const float l3 = base, l2 = l3 + s1[4 * a + 3], l1 = l2 + s1[4 * a + 2], l0 = l1 + s1[4 * a + 1];
                p1[4 * a + 3] = __builtin_amdgcn_exp2f(p1[4 * a + 3] - l3); p1[4 * a + 2] = __builtin_amdgcn_exp2f(p1[4 * a + 2] - l2); p1[4 * a + 1] = __builtin_amdgcn_exp2f(p1[4 * a + 1] - l1); p1[4 * a] = __builtin_amdgcn_exp2f(p1[4 * a] - l0);
                suf += gsum[4 + a] + pg[4 + a]; }
#pragma unroll
            for (int a = 3; a >= 0; --a) { const float base = R + suf + (hi ? 0.f : pg[a]);
                const float l3 = base, l2 = l3 + s0[4 * a + 3], l1 = l2 + s0[4 * a + 2], l0 = l1 + s0[4 * a + 1];
                p0[4 * a + 3] = __builtin_amdgcn_exp2f(p0[4 * a + 3] - l3); p0[4 * a + 2] = __builtin_amdgcn_exp2f(p0[4 * a + 2] - l2); p0[4 * a + 1] = __builtin_amdgcn_exp2f(p0[4 * a + 1] - l1); p0[4 * a] = __builtin_amdgcn_exp2f(p0[4 * a] - l0);
                suf += gsum[a] + pg[a]; }
            R += suf;
            bf16x8 pa0, pa1, pa2, pa3; p_to_frags(p0, p1, pa0, pa1, pa2, pa3);
            pv_d0(o, vb, pa0, pa1, pa2, pa3);
            done = __all(R >= 160.f);
        }
        if (lane == 0) ((LAS unsigned*)(lds + ATT_FLAG))[8 * (it & 1) + wave] = done ? 1u : 0u; });
    scale_store<3>(o, 1.f, li_l, r32, hi, nullptr, (bf16*)(ws + WS_OC) + mrow0 * D + 2048 + h * HD, 0, D);
}

__device__ __forceinline__ void sb_naive(const Ptrs& P, int gw, int NGW, int lane) {
    unsigned char* ws = P.ws; const bf16* HQ = (const bf16*)(ws + WS_HQ); bf16* OC = (bf16*)(ws + WS_OC);
    for (int item = gw; item < M * 16; item += NGW) { const int m = item >> 4, h = item & 15, t = m & (T - 1);
        const bf16* q = HQ + ((size_t)(C_QB / HD + h) * M + m) * HD + 2 * lane; const float q0 = bf2f(q[0]), q1 = bf2f(q[1]);
        float o0 = 0.f, o1 = 0.f, later = 0.f;
        for (int s = t - 1; s >= 0 && later < 111.f; --s) {
            const bf16* kr = HQ + ((size_t)(C_KB / HD + h) * M + (m - t + s)) * HD + 2 * lane; const bf16* vr = HQ + ((size_t)(C_VB / HD + h) * M + (m - t + s)) * HD + 2 * lane;
            const float z = wave_sum(q0 * bf2f(kr[0]) + q1 * bf2f(kr[1])) * SCALE;
            const float sp = fmaxf(z, 0.f) + __logf(1.f + __expf(-fabsf(z))), a = __expf(z - sp - later);
            o0 += a * bf2f(vr[0]); o1 += a * bf2f(vr[1]); later += sp; }
        *(unsigned*)(OC + (size_t)m * D + 2048 + h * HD + 2 * lane) = cvtpk(o0, o1); }
}
#ifndef MK_SB_NAIVE
#define MK_SB_NAIVE 0
#endif
#ifndef MK_ATT_MASK
#define MK_ATT_MASK 3
#endif
__device__ __forceinline__ int pop_unit(unsigned* heads, int per_queue, int home, LAS unsigned* uq, int tid) {
    __syncthreads();
    if (tid == 0) { int r = -1;
        const unsigned idx = __hip_atomic_fetch_add(heads + 64 * home, 1u, __ATOMIC_RELAXED, __HIP_MEMORY_SCOPE_AGENT);
        if (idx < (unsigned)per_queue) r = home * per_queue + (int)idx;
        else for (int attempt = 0; attempt < 8; ++attempt) {
            unsigned h0, h1, h2, h3, h4, h5, h6, h7; const unsigned zero = 0u;
            asm volatile("global_load_dword %0, %8, %9 sc1\n\tglobal_load_dword %1, %8, %9 offset:256 sc1\n\tglobal_load_dword %2, %8, %9 offset:512 sc1\n\tglobal_load_dword %3, %8, %9 offset:768 sc1\n\t"
                         "global_load_dword %4, %8, %9 offset:1024 sc1\n\tglobal_load_dword %5, %8, %9 offset:1280 sc1\n\tglobal_load_dword %6, %8, %9 offset:1536 sc1\n\tglobal_load_dword %7, %8, %9 offset:1792 sc1\n\ts_waitcnt vmcnt(0)"
                         : "=&v"(h0), "=&v"(h1), "=&v"(h2), "=&v"(h3), "=&v"(h4), "=&v"(h5), "=&v"(h6), "=&v"(h7) : "v"(zero), "s"(heads) : "memory");
            int q = -1;
#pragma unroll
            for (int k = 7; k >= 0; --k) { const int qq = (home + k) & 7; const unsigned hv = qq == 0 ? h0 : qq == 1 ? h1 : qq == 2 ? h2 : qq == 3 ? h3 : qq == 4 ? h4 : qq == 5 ? h5 : qq == 6 ? h6 : h7; if (hv < (unsigned)per_queue) q = qq; }
            if (q < 0) break;
            const unsigned i2 = __hip_atomic_fetch_add(heads + 64 * q, 1u, __ATOMIC_RELAXED, __HIP_MEMORY_SCOPE_AGENT);
            if (i2 < (unsigned)per_queue) { r = q * per_queue + (int)i2; break; } }
        uq[0] = (unsigned)r; }
    __syncthreads();
    return __builtin_amdgcn_readfirstlane((int)uq[0]);
}
__device__ __forceinline__ void attention_phase(const Ptrs& P, LAS unsigned char* lds, unsigned* ctl, int tid, int wave, int lane, int amask = 3) {
    LAS unsigned* uq = (LAS unsigned*)(lds + ATT_FLAG + 128);
    const int home = (int)(xb_xcc_id() & 7u);
    if (MK_SB_NAIVE) { if (amask & 2) sb_naive(P, blockIdx.x * NWAVES + wave, gridDim.x * NWAVES, lane); }
    if (MK_ATT_MASK & amask & 1) for (;;) {
        const int r = pop_unit(ctl + CW_QNSA, 128, home, uq, tid); if (r < 0) break;
        const int q = r >> 7, idx = r & 127, combo = q + 8 * (idx >> 5), qt = 31 - (idx & 31);
        nsa_unit(P, lds, combo, qt, tid, wave, lane);
    }
    if (!MK_SB_NAIVE && (MK_ATT_MASK & amask & 2)) for (;;) {
        const int r = pop_unit(ctl + CW_QSB, 128, home, uq, tid); if (r < 0) break;
        const int q = r >> 7, idx = r & 127, combo = q + 8 * (idx >> 3), qt = 7 - (idx & 7);
        sb_unit(P, lds, combo, qt, tid, wave, lane);
    }
}
}

struct Args { const float* in[17]; float* out; unsigned char* ws; int ph_lo, ph_hi; };
__global__ void __launch_bounds__(NWAVES * 64, 2) fwd_kernel(Args args) {
    extern __shared__ __attribute__((aligned(16))) unsigned char lds_raw[];
    LAS unsigned char* lds = (LAS unsigned char*)lds_raw;
    volatile LAS unsigned* MISC = (volatile LAS unsigned*)(lds + MISC_OFF);
    const int tid = threadIdx.x, lane = tid & 63, wave = __builtin_amdgcn_readfirstlane(tid >> 6);
    const int G = gridDim.x, gw = blockIdx.x * NWAVES + wave, NGW = G * NWAVES;
    Ptrs P;
    P.x = args.in[0]; P.w_in = args.in[1]; P.w_out = args.in[2]; P.cmp_wk = args.in[3]; P.cmp_wv = args.in[4]; P.pe_k = args.in[5]; P.pe_v = args.in[6]; P.pool_w = args.in[7]; P.pool_scale = args.in[8];
    P.w_up = args.in[9]; P.conv_w = args.in[10]; P.conv_b = args.in[11]; P.w_down = args.in[12]; P.ln_mix_g = args.in[13]; P.ln_mix_b = args.in[14]; P.ln_ffn_g = args.in[15]; P.ln_ffn_b = args.in[16];
    P.out = args.out; P.ws = args.ws;
    unsigned char* ws = args.ws; unsigned* ctl = (unsigned*)(ws + WS_CTL);
    if (tid < 16) MISC[tid] = 0u;
    __syncthreads();
    XcdBarrier bar; bar.bar = ctl + CW_BAR; bar.x = 0; bar.st = nullptr;
    if (!MK_PER_PHASE) bar = xcd_barrier_post(ctl + CW_BAR, MISC);
    const int lo = args.ph_lo, hi = args.ph_hi;
#ifndef MK_PHASE_MASK
#define MK_PHASE_MASK 0xFFFFFFFFu
#endif
#define IN(k) (((MK_PHASE_MASK >> (k)) & 1u) && lo <= (k) && (k) < hi)
#define SEAM(k) do { if (IN(k) && IN((k) + 1)) xcd_barrier(bar); } while (0)
#ifndef MK_DUP_MASK
#define MK_DUP_MASK 0u
#endif
#define REPS(k) ((((MK_DUP_MASK) >> (k)) & 1u) ? 2 : 1)
    bf16* XB = (bf16*)(ws + WS_XB); _Float16* Y = (_Float16*)(ws + WS_Y); bf16* A2 = (bf16*)(ws + WS_A2); bf16* HQ = (bf16*)(ws + WS_HQ); bf16* OC = (bf16*)(ws + WS_OC); float* HALO = (float*)(ws + WS_H);

    float* STATS = (float*)(ws + WS_STATS); float* COLS = (float*)(ws + WS_COLS);
#define PHASE(k, ...) if (IN(k)) for (int rep = 0; rep < REPS(k); ++rep) { if (rep) xcd_barrier(bar); __VA_ARGS__ } SEAM(k)
#ifndef MK_DOWN_WGM
#define MK_DOWN_WGM 4
#endif
#ifndef MK_OUT_WGM
#define MK_OUT_WGM 4
#endif
#define GEMM_WGM 8
#define GEMM_PHASE(EPI, ALIGN, A_, BT_, N_, K_, LDA_, LDB_, AGRP_, ...) { pg8::Gemm g{A_, BT_, M, N_, K_, LDA_, LDB_, AGRP_}; pg8::StaticOrder S; S.init(M, N_, G, (int)blockIdx.x); S.wgm = GEMM_WGM; S.pair = (GEMM_WGM == 4 && G == 256) ? 1 : 0; \
        pg8::EPI E{__VA_ARGS__}; pg8::gemm_phase<pg8::EPI, pg8::StaticOrder, ALIGN, PG8_SP2>(lds + RING_OFF, g, S, E); }
    PHASE(0, p0_prologue(P, lds, gw, NGW, wave, lane););
    PHASE(1, GEMM_PHASE(EpiInProj, PG8_ALIGN, XB, (const bf16*)(ws + WS_WINT), LDH, D, D, D, 0, HQ, M, (const float*)(ws + WS_COS), (const float*)(ws + WS_SIN)));
    PHASE(2, compress_phase(P, lds, gw, NGW, wave, lane););
#ifndef MK_DIAG
#define MK_DIAG 0
#endif
#ifndef MK_DUP_ATT
#define MK_DUP_ATT 3
#endif
    if (IN(3)) { if (MK_DIAG == 1) { v4u* z = (v4u*)OC; for (size_t i = (size_t)blockIdx.x * 512 + tid; i < (size_t)M * D * 2 / 16; i += (size_t)G * 512) z[i] = (v4u){0u, 0u, 0u, 0u}; }
        else for (int rep = 0; rep < REPS(3); ++rep) { if (rep) xcd_barrier(bar); at::attention_phase(P, lds, ctl + 8192 * rep, tid, wave, lane, rep ? MK_DUP_ATT : 3); } } SEAM(3);
#undef GEMM_WGM
#define GEMM_WGM MK_OUT_WGM
    PHASE(4, GEMM_PHASE(EpiResStats, PG8_ALIGN, OC, (const bf16*)(ws + WS_WOUTT), D, D, D, D, 0, Y, P.x, nullptr, nullptr, nullptr, nullptr, D, ALPHA));
#undef GEMM_WGM
#define GEMM_WGM 8
    PHASE(5, ln_light(Y, STATS, XB, gw, NGW, lane); finalize_cols((const float*)(ws + WS_COLP), COLS, (float*)(ws + WS_RPART), P.conv_w, P.conv_b, gw, NGW, lane););
    PHASE(6, GEMM_PHASE(EpiUpConv, true, XB, (const bf16*)(ws + WS_WUP0T), NUP, D, D, D, 0, A2, (const float*)(ws + WS_RPART), HALO, lds + XCH_OFF, DFF, NUP));
    PHASE(7, conv_fix(HALO, COLS, P.conv_w, P.conv_b, A2, G, tid););
#undef GEMM_WGM
#define GEMM_WGM MK_DOWN_WGM
    PHASE(8, GEMM_PHASE(EpiResStats, PG8_ALIGN, A2, (const bf16*)(ws + WS_WDN0T), D, DFF, DFF, DFF, 0, Y, nullptr, STATS, P.ln_mix_g, P.ln_mix_b, nullptr, D, ALPHA));
#undef GEMM_WGM
#define GEMM_WGM 8
    PHASE(10, pool_diff(Y, STATS, P.ln_ffn_g, XB, (LAS float*)(lds + RING_OFF), G, tid, wave, lane););
#undef GEMM_WGM
#define GEMM_WGM MK_OUT_WGM
    PHASE(11, GEMM_PHASE(EpiResStats, PG8_ALIGN, XB, (const bf16*)(ws + WS_WPOOLT), D, 1024, D, 1024, 4, Y, nullptr, STATS, P.ln_ffn_g, P.ln_ffn_b, P.pool_scale, D, ALPHA));
#undef GEMM_WGM
#define GEMM_WGM 8
    PHASE(12, ln_light(Y, STATS, XB, gw, NGW, lane););
    PHASE(13, GEMM_PHASE(EpiUpConv, true, XB, (const bf16*)(ws + WS_WUP1T), NUP, D, D, D, 0, A2, (const float*)(ws + WS_RPART) + (size_t)(NUP / 256) * 4 * 64 * 4, HALO, lds + XCH_OFF, DFF, NUP));
    PHASE(14, conv_fix(HALO, COLS + (size_t)3 * NUP, P.conv_w + (size_t)3 * NUP, P.conv_b + NUP, A2, G, tid););
#undef GEMM_WGM
#define GEMM_WGM MK_DOWN_WGM
    PHASE(15, GEMM_PHASE(EpiResStats, PG8_ALIGN, A2, (const bf16*)(ws + WS_WDN1T), D, DFF, DFF, DFF, 0, Y, nullptr, STATS, P.ln_mix_g + D, P.ln_mix_b + D, nullptr, D, ALPHA));
#undef GEMM_WGM
#define GEMM_WGM 8
    if (IN(16)) for (int rep = 0; rep < REPS(16); ++rep) { if (rep) xcd_barrier(bar); ln_rows(Y, P.ln_ffn_g + D, P.ln_ffn_b + D, P.out, nullptr, gw, NGW, lane); }
#undef PHASE
#undef GEMM_PHASE
#undef IN
#undef SEAM
}

extern "C" void kernel_launch(void* const* d_in, const int* in_sizes, int n_in, void* d_out, int out_size, void* d_ws, size_t ws_size, hipStream_t stream) {
    static int grid = 0;
    if (grid == 0) {
        if (n_in != 17 || in_sizes[0] != M * D || out_size != M * D || ws_size < WS_END) { fprintf(stderr, "kernel_launch: built for 17 inputs, x/out of %d floats, >= %zu bytes of workspace; got n_in %d, in0 %d, out %d, ws %zu; nothing launched\n", M * D, (size_t)WS_END, n_in, n_in > 0 ? in_sizes[0] : -1, out_size, ws_size); grid = -1; return; }
        int dev = 0, cus = 0, per_cu = 0;
        if (hipGetDevice(&dev) != hipSuccess || hipDeviceGetAttribute(&cus, hipDeviceAttributeMultiprocessorCount, dev) != hipSuccess) { fprintf(stderr, "kernel_launch: hipGetDevice / hipDeviceGetAttribute failed\n"); grid = -1; return; }
        if (hipFuncSetAttribute((const void*)fwd_kernel, hipFuncAttributeMaxDynamicSharedMemorySize, LDS_BYTES) != hipSuccess) { fprintf(stderr, "kernel_launch: hipFuncSetAttribute(%d B LDS) failed\n", LDS_BYTES); grid = -1; return; }
        if (hipOccupancyMaxActiveBlocksPerMultiprocessor(&per_cu, (const void*)fwd_kernel, NWAVES * 64, LDS_BYTES) != hipSuccess || per_cu < 1)
            fprintf(stderr, "kernel_launch: note: occupancy query reports %d workgroups per CU\n", per_cu);
        (void)hipGetLastError();
        grid = cus;
    }
    if (grid < 0) return;
    if (hipMemsetAsync((char*)d_ws + WS_CTL, 0, CTL_ZERO_BYTES, stream) != hipSuccess) { fprintf(stderr, "kernel_launch: hipMemsetAsync failed\n"); return; }
    Args a{};
    for (int i = 0; i < 17; ++i) a.in[i] = (const float*)d_in[i];
    a.out = (float*)d_out; a.ws = (unsigned char*)d_ws;
#if MK_PER_PHASE
    for (int ph = 0; ph < N_PHASES; ++ph) { a.ph_lo = ph; a.ph_hi = ph + 1;
        hipLaunchKernelGGL(fwd_kernel, dim3(grid), dim3(NWAVES * 64), LDS_BYTES, stream, a); }
#else
    a.ph_lo = 0; a.ph_hi = N_PHASES;
    hipLaunchKernelGGL(fwd_kernel, dim3(grid), dim3(NWAVES * 64), LDS_BYTES, stream, a);
#endif
    const hipError_t le = hipPeekAtLastError();
    if (le != hipSuccess) fprintf(stderr, "kernel_launch: launch failed: %s (grid %d x %d threads, %d B LDS)\n", hipGetErrorName(le), grid, NWAVES * 64, LDS_BYTES);
}
```
